# Optimizing an MI355X kernel written in HIP

```python
import jax, jax.numpy as jnp
from jax import lax
import numpy as np

D_MODEL = 2048
BATCH = 4
SEQ = 2048
DEPTH = 1
DEC_BATCH = 128
DEC_SEQ = 1
PAST_LEN = 16384
PAGE_SIZE = 128

D_PLE = 256
D_A = D_MODEL // 2
HD_A = 64
H_A = D_A // HD_A
LORA_W = 64
LORA_A = 64
D_B = D_MODEL - D_A
H_B = 4
HD_B = D_B // H_B
CHUNK = 128
ROPE_BASE = 10000.0
RMS_EPS = 1e-6
GN_EPS_A = HD_A * 1e-5
GN_EPS_B = 1e-5

A_SHIFT = 3 * D_A + LORA_W + LORA_A
OFF_GA = A_SHIFT
OFF_B = A_SHIFT + D_A
N_COLS = OFF_B + 4 * D_B

kernel_name = "hybrid_rwkv7_retention_decode_step"


def rmsnorm(x, g):
    xf = x.astype(jnp.float32)
    y = xf * lax.rsqrt(jnp.mean(xf * xf, axis=-1, keepdims=True) + RMS_EPS)
    return (y * g.astype(jnp.float32)).astype(x.dtype)


def head_norm(x, g, b, eps):
    mu = jnp.mean(x, axis=-1, keepdims=True)
    xc = x - mu
    var = jnp.mean(xc * xc, axis=-1, keepdims=True)
    y = (xc * lax.rsqrt(var + eps)).reshape(x.shape[:-2] + (-1,))
    return y * g.astype(jnp.float32) + b.astype(jnp.float32)


def rotary_every_two(x, pos):
    d = x.shape[-1]
    angle = 1.0 / (ROPE_BASE ** jnp.linspace(0.0, 1.0, d // 2, dtype=jnp.float32))
    theta = pos[:, None] * angle[None, :]
    cos = jnp.cos(theta)[None, :, None, :]
    sin = jnp.sin(theta)[None, :, None, :]
    xp = x.reshape(x.shape[:-1] + (d // 2, 2))
    x1, x2 = xp[..., 0], xp[..., 1]
    out = jnp.stack([x1 * cos - x2 * sin, x1 * sin + x2 * cos], axis=-1)
    return out.reshape(x.shape)


def rwkv7_scan(S0, r, w, k, v, a_vec, b_vec):
    def step(S, inp):
        r_t, w_t, k_t, v_t, a_t, b_t = inp
        sa = jnp.einsum('bhvk,bhk->bhv', S, a_t)
        S = S * w_t[:, :, None, :] + sa[..., None] * b_t[:, :, None, :] + v_t[..., None] * k_t[:, :, None, :]
        y = jnp.einsum('bhvk,bhk->bhv', S, r_t)
        return S, y
    xs = tuple(jnp.swapaxes(t, 0, 1) for t in (r, w, k, v, a_vec, b_vec))
    S_T, ys = lax.scan(step, S0, xs)
    return jnp.swapaxes(ys, 0, 1), S_T


def retention_chunk(S0, q, k, v, lg):
    L = q.shape[2]
    idx = jnp.arange(L, dtype=jnp.float32)
    diff = idx[:, None] - idx[None, :]
    dmask = jnp.where(diff >= 0, jnp.exp(jnp.maximum(diff, 0.0)[None] * lg[:, None, None]), 0.0)
    scores = jnp.einsum('bhid,bhjd->bhij', q, k) * dmask[None]
    inner = jnp.einsum('bhij,bhjv->bhiv', scores, v)
    cross = jnp.einsum('bhid,bhdv->bhiv', q, S0) * jnp.exp((idx + 1.0)[None, :] * lg[:, None])[None, :, :, None]
    kdec = jnp.exp((L - 1.0 - idx)[None, :] * lg[:, None])
    S_new = S0 * jnp.exp(L * lg)[None, :, None, None] + jnp.einsum('bhjd,bhjv,hj->bhdv', k, v, kdec)
    return inner + cross, S_new


def retention(S0, q, k, v, lg):
    B, H, T, _ = q.shape
    chunk = CHUNK if T % CHUNK == 0 else T
    nc = T // chunk
    def to_chunks(t):
        return jnp.moveaxis(t.reshape(B, H, nc, chunk, t.shape[-1]), 2, 0)
    def step(S, inp):
        qc, kc, vc = inp
        o, S = retention_chunk(S, qc, kc, vc, lg)
        return S, o
    S_T, os_ = lax.scan(step, S0, (to_chunks(q), to_chunks(k), to_chunks(v)))
    out = jnp.moveaxis(os_, 0, 2).reshape(B, H, T, v.shape[-1])
    return out, S_T


def hybrid_layer(h, p, pos, wkv0, shift0, ret0, g_ln, w_in, mu_shift, w0, w_wB, a0, w_aB, k_k, k_a, r_k,
                 gn_a_g, gn_a_b, gn_b_g, gn_b_b, w_out, w_ple, w_ple_gate):
    B, T, _ = h.shape
    f32 = jnp.float32
    u = rmsnorm(h, g_ln)
    z = u @ w_in

    feats = z[..., :A_SHIFT]
    prev = jnp.concatenate([shift0[:, None].astype(feats.dtype), feats[:, :-1]], axis=1)
    xs = (feats + mu_shift * (prev - feats)).astype(f32)
    r = xs[..., :D_A]
    k = xs[..., D_A:2 * D_A]
    v = xs[..., 2 * D_A:3 * D_A]
    w_lo = xs[..., 3 * D_A:3 * D_A + LORA_W]
    a_lo = xs[..., 3 * D_A + LORA_W:]
    w_log = -jax.nn.softplus(-(w0.astype(f32) + jnp.tanh(w_lo) @ w_wB.astype(f32))) - 0.5
    decay = jnp.exp(-jnp.exp(w_log))
    a = jax.nn.sigmoid(a0.astype(f32) + a_lo @ w_aB.astype(f32))
    hs = lambda t: t.reshape(B, T, H_A, HD_A)
    kk = hs(k * k_k.astype(f32))
    kk = kk / jnp.maximum(jnp.sqrt(jnp.sum(kk * kk, axis=-1, keepdims=True)), 1e-12)
    k = k * (1.0 + (a - 1.0) * k_a.astype(f32))
    r4, k4, v4, a4 = hs(r), hs(k), hs(v), hs(a)
    y_a, wkv_T = rwkv7_scan(wkv0.astype(f32), r4, hs(decay), k4, v4, -kk, kk * a4)
    bonus = (jnp.sum(r4 * k4 * r_k.astype(f32), axis=-1, keepdims=True) * v4).reshape(B, T, D_A)
    y_a = (head_norm(y_a, gn_a_g, gn_a_b, GN_EPS_A) + bonus) * jax.nn.silu(z[..., OFF_GA:OFF_GA + D_A].astype(f32))

    hb = lambda t: t.astype(f32).reshape(B, T, H_B, HD_B)
    qb = rotary_every_two(hb(z[..., OFF_B:OFF_B + D_B]), pos)
    kb = rotary_every_two(hb(z[..., OFF_B + D_B:OFF_B + 2 * D_B]), pos) * (HD_B ** -0.5)
    vb = hb(z[..., OFF_B + 2 * D_B:OFF_B + 3 * D_B])
    gb = z[..., OFF_B + 3 * D_B:].astype(f32)
    lg = jnp.log(1.0 - jnp.exp2(-5.0 - jnp.arange(H_B, dtype=f32)))
    to_bh = lambda t: jnp.transpose(t, (0, 2, 1, 3))
    y_b, ret_T = retention(ret0.astype(f32), to_bh(qb), to_bh(kb), to_bh(vb), lg)
    y_b = head_norm(to_bh(y_b), gn_b_g, gn_b_b, GN_EPS_B) * jax.nn.silu(gb)

    mix = jnp.concatenate([y_a, y_b], axis=-1).astype(h.dtype)
    h = h + mix @ w_out
    h = h + jax.nn.sigmoid(h @ w_ple_gate) * (p @ w_ple)
    return h, wkv_T, feats[:, -1], ret_T


def setup_inputs(seed: int = 0) -> dict:
    key = jax.random.key(seed)
    ks = jax.random.split(key, 32)
    f32 = jnp.float32
    nrm = lambda k, s, sc: jax.random.normal(k, s, f32) * sc
    return {
        "x_prompt": nrm(ks[0], (BATCH, SEQ, D_MODEL), 1.0),
        "x_sample": nrm(ks[1], (DEC_BATCH, DEC_SEQ, D_MODEL), 1.0),
        "p_prompt": nrm(ks[2], (DEPTH, BATCH, SEQ, D_PLE), 1.0),
        "p_sample": nrm(ks[3], (DEPTH, DEC_BATCH, DEC_SEQ, D_PLE), 1.0),
        "state_wkv": nrm(ks[4], (DEPTH, DEC_BATCH, H_A, HD_A, HD_A), 0.5),
        "state_shift": nrm(ks[5], (DEPTH, DEC_BATCH, A_SHIFT), 1.0),
        "state_ret": nrm(ks[6], (DEPTH, DEC_BATCH, H_B, HD_B, HD_B), 1.0),
        "g_ln": 1.0 + nrm(ks[7], (DEPTH, D_MODEL), 0.02),
        "w_in": nrm(ks[8], (DEPTH, D_MODEL, N_COLS), D_MODEL ** -0.5),
        "mu_shift": jax.random.uniform(ks[9], (DEPTH, A_SHIFT), f32, 0.0, 1.0),
        "w0": jax.random.uniform(ks[10], (DEPTH, D_A), f32, -5.0, 0.0),
        "w_wB": nrm(ks[11], (DEPTH, LORA_W, D_A), 0.1 * LORA_W ** -0.5),
        "a0": nrm(ks[12], (DEPTH, D_A), 0.1),
        "w_aB": nrm(ks[13], (DEPTH, LORA_A, D_A), 0.1 * LORA_A ** -0.5),
        "k_k": 0.85 + nrm(ks[14], (DEPTH, D_A), 0.02),
        "k_a": 1.0 + nrm(ks[15], (DEPTH, D_A), 0.02),
        "r_k": nrm(ks[16], (DEPTH, H_A, HD_A), 0.1),
        "gn_a_g": 1.0 + nrm(ks[17], (DEPTH, D_A), 0.02),
        "gn_a_b": nrm(ks[18], (DEPTH, D_A), 0.02),
        "gn_b_g": 1.0 + nrm(ks[19], (DEPTH, D_B), 0.02),
        "gn_b_b": nrm(ks[20], (DEPTH, D_B), 0.02),
        "w_out": nrm(ks[21], (DEPTH, D_A + D_B, D_MODEL), (D_A + D_B) ** -0.5),
        "w_ple": nrm(ks[22], (DEPTH, D_PLE, D_MODEL), D_PLE ** -0.5),
        "w_ple_gate": nrm(ks[23], (DEPTH, D_MODEL, D_MODEL), D_MODEL ** -0.5),
        "g_final": 1.0 + nrm(ks[24], (D_MODEL,), 0.02),
    }


def reference(x_prompt, x_sample, p_prompt, p_sample, state_wkv, state_shift, state_ret, g_ln, w_in, mu_shift,
              w0, w_wB, a0, w_aB, k_k, k_a, r_k, gn_a_g, gn_a_b, gn_b_g, gn_b_b, w_out, w_ple, w_ple_gate, g_final):
    f32 = jnp.float32
    Bp, Tp, _ = x_prompt.shape
    Bs, Ts, _ = x_sample.shape
    pos_p = jnp.arange(Tp, dtype=f32)
    pos_s = (PAST_LEN + jnp.arange(Ts)).astype(f32)
    hp, hs_ = x_prompt, x_sample
    wkv_p, shift_p, ret_p, wkv_s, shift_s, ret_s = [], [], [], [], [], []
    for i in range(DEPTH):
        lw = (g_ln[i], w_in[i], mu_shift[i], w0[i], w_wB[i], a0[i], w_aB[i], k_k[i], k_a[i], r_k[i],
              gn_a_g[i], gn_a_b[i], gn_b_g[i], gn_b_b[i], w_out[i], w_ple[i], w_ple_gate[i])
        hp, s1, s2, s3 = hybrid_layer(hp, p_prompt[i], pos_p,
                                      jnp.zeros((Bp, H_A, HD_A, HD_A), f32),
                                      jnp.zeros((Bp, A_SHIFT), x_prompt.dtype),
                                      jnp.zeros((Bp, H_B, HD_B, HD_B), f32), *lw)
        wkv_p.append(s1); shift_p.append(s2); ret_p.append(s3)
        hs_, s1, s2, s3 = hybrid_layer(hs_, p_sample[i], pos_s, state_wkv[i], state_shift[i], state_ret[i], *lw)
        wkv_s.append(s1); shift_s.append(s2); ret_s.append(s3)
    y_prompt = rmsnorm(hp, g_final)
    y_sample = rmsnorm(hs_, g_final)
    return (y_prompt, y_sample, jnp.stack(wkv_p), jnp.stack(shift_p), jnp.stack(ret_p),
            jnp.stack(wkv_s), jnp.stack(shift_s), jnp.stack(ret_s))
```

```cpp
#include <hip/hip_runtime.h>
#include <hip/hip_cooperative_groups.h>
#include <cstdio>
#include <cstdint>
namespace cg = cooperative_groups;
namespace pg8 {
#define PG8_LAS __attribute__((address_space(3)))
typedef unsigned short bf16_t;
typedef short bf16x8 __attribute__((ext_vector_type(8)));
typedef float f32x4 __attribute__((ext_vector_type(4)));
typedef unsigned u32x4 __attribute__((ext_vector_type(4)));
constexpr int BM = 256, BK = 64, HALF = 128, HTB = HALF * BK * 2  , STAGE_BYTES = 8 * HTB, NXCD = 8, WGM = 8;

__host__ __device__ __forceinline__ int lds_byte(int r, int c) { const int st = (r >> 4) * 2 + (c >> 5), rr = r & 15, cc = c & 31, ob = rr * 64 + cc * 2; return st * 1024 + (ob ^ (((ob >> 9) & 1) << 5)); }
__host__ __device__ __forceinline__ void stage_rc(int b, int& R, int& C) { const int st = b / 1024, sb = b % 1024, swz = sb ^ (((sb >> 9) & 1) << 5); R = (st >> 1) * 16 + swz / 64; C = (st & 1) * 32 + (swz % 64) / 2; }
__host__ __device__ __forceinline__ int perm32(int rho) { const int n = rho >> 4, i = rho & 15; return 8 * (i >> 2) + 4 * n + (i & 3); }

struct Unit { int pm, pn; };
struct Gemm { const bf16_t* A; const bf16_t* Bt; int M, N, K; };

struct StaticOrder {
    int nM, nN, nwg, G, c;
    __host__ __device__ void init(int M, int N, int G_, int c_) { nM = M / BM; nN = N / BM; nwg = nM * nN; G = G_; c = c_; }
    __host__ __device__ bool next(int i, Unit& u) const {
        const long L = (long)i * G + c; if (L >= nwg) return false;
        int wgid = (int)L; { const int q = nwg / NXCD, r = nwg % NXCD, xcd = wgid % NXCD, off = wgid / NXCD; wgid = (xcd < r ? xcd * (q + 1) : r * (q + 1) + (xcd - r) * q) + off; }
        const int nig = WGM * nN, gid = wgid / nig, fm = gid * WGM, gsz = (nM - fm) < WGM ? (nM - fm) : WGM;
        u.pm = fm + ((wgid % nig) % gsz); u.pn = (wgid % nig) / gsz; return true;
    }
    __device__ __forceinline__ void a_ready(const Unit&) const {}
    __device__ __forceinline__ void done(const Unit&) const {}
};
__device__ __forceinline__ unsigned cvt_pk_bf16(float lo, float hi) { unsigned r; asm volatile("v_cvt_pk_bf16_f32 %0, %1, %2" : "=v"(r) : "v"(lo), "v"(hi)); return r; }
typedef float f32x2 __attribute__((ext_vector_type(2)));
template <class Epi, class Sched, bool ALIGN_EPI = false, bool SP2 = false>
__device__ __forceinline__ void gemm_phase(PG8_LAS unsigned char* lds, const Gemm g, const Sched& S, const Epi& E) {
    const int tid = threadIdx.x, wid = __builtin_amdgcn_readfirstlane(tid >> 6), lane = tid & 63, wr = wid >> 2, wc = wid & 3, fr = lane & 15, fq = lane >> 4;
    const int K = g.K, nt = K / BK;
    unsigned voffA[2], voffB[2];
#pragma unroll
    for (int i = 0; i < 2; ++i) { int R, C; stage_rc(tid * 16 + i * 8192, R, C); const int Rb = Epi::PERM ? ((R & ~31) + perm32(R & 31)) : R;
        voffA[i] = (unsigned)(R * K + C) * 2u; voffB[i] = (unsigned)(Rb * K + C) * 2u; }
    const size_t kstep = (size_t)(BK * 2);
    const size_t hstep = (size_t)HALF * K * 2;
    const size_t tstep = 2 * hstep;
    const unsigned ldsw = (unsigned)wid * 1024u;
    const int aoff = lds_byte(wr * 64 + fr, fq * 8), boff = lds_byte(wc * 32 + fr, fq * 8);
#define PG8_SA(b, h) (((b) * 2 + (h)) * HTB)
#define PG8_SB(b, h) ((4 + (b) * 2 + (h)) * HTB)
#define PG8_STAGE(bufoff, gbase, voff) do { _Pragma("unroll") for (int _i = 0; _i < 2; ++_i) \
        __builtin_amdgcn_global_load_lds((const unsigned*)((const char*)(gbase) + (voff)[_i]), (PG8_LAS unsigned*)(lds + (bufoff) + ldsw + _i * 8192), 16, 0, 0); } while (0)
#define PG8_LDA(dst, b, h) do { _Pragma("unroll") for (int m = 0; m < 4; ++m) _Pragma("unroll") for (int k = 0; k < 2; ++k) dst[m][k] = *(const PG8_LAS bf16x8*)(lds + PG8_SA(b, h) + aoff + m * 2048 + k * 1024); } while (0)
#define PG8_LDB(dst, b, h) do { _Pragma("unroll") for (int n = 0; n < 2; ++n) _Pragma("unroll") for (int k = 0; k < 2; ++k) dst[n][k] = *(const PG8_LAS bf16x8*)(lds + PG8_SB(b, h) + boff + n * 2048 + k * 1024); } while (0)
#define PG8_MMA(ai, bj, At, Bt) do { __builtin_amdgcn_s_setprio(1); _Pragma("unroll") for (int m = 0; m < 4; ++m) _Pragma("unroll") for (int n = 0; n < 2; ++n) _Pragma("unroll") for (int k = 0; k < 2; ++k) \
        acc[ai][bj][m][n] = __builtin_amdgcn_mfma_f32_16x16x32_bf16(Bt[n][k], At[m][k], acc[ai][bj][m][n], 0, 0, 0); __builtin_amdgcn_s_setprio(0); } while (0)
#define PG8_WAIT_V(n) asm volatile("s_waitcnt vmcnt(" #n ")" ::: "memory")
#define PG8_WAIT_L(n) asm volatile("s_waitcnt lgkmcnt(" #n ")" ::: "memory")
#define PG8_BAR __builtin_amdgcn_s_barrier()
#define PG8_SCHED __builtin_amdgcn_sched_barrier(0)
    Unit cur, nxt; int ui = 0;
    if (!S.next(0, cur)) return;
    f32x4 acc[2][2][4][2];
#pragma unroll
    for (int a = 0; a < 2; ++a)
#pragma unroll
        for (int b = 0; b < 2; ++b)
#pragma unroll
            for (int m = 0; m < 4; ++m)
#pragma unroll
                for (int n = 0; n < 2; ++n) acc[a][b][m][n] = (f32x4){0.f, 0.f, 0.f, 0.f};
    bf16x8 At[4][2], B0[2][2], B1[2][2];
    const char* cA = (const char*)g.A + (size_t)cur.pm * tstep; const char* cB = (const char*)g.Bt + (size_t)cur.pn * tstep;
    S.a_ready(cur);
    if constexpr (SP2) {
        PG8_STAGE(PG8_SB(0, 0), cB, voffB); PG8_STAGE(PG8_SB(0, 1), cB + hstep, voffB); PG8_STAGE(PG8_SA(0, 0), cA, voffA); PG8_STAGE(PG8_SA(0, 1), cA + hstep, voffA);
        if (wr == 1) PG8_BAR;
        PG8_WAIT_V(2); PG8_BAR;
        PG8_STAGE(PG8_SB(1, 0), cB + kstep, voffB); PG8_STAGE(PG8_SA(1, 0), cA + kstep, voffA); PG8_STAGE(PG8_SB(1, 1), cB + hstep + kstep, voffB);
        PG8_WAIT_V(6); PG8_BAR;
    } else {
        PG8_STAGE(PG8_SB(0, 0), cB, voffB); PG8_STAGE(PG8_SA(0, 0), cA, voffA); PG8_STAGE(PG8_SB(0, 1), cB + hstep, voffB); PG8_STAGE(PG8_SA(0, 1), cA + hstep, voffA);
        if (wr == 1) PG8_BAR;
        PG8_WAIT_V(4); PG8_BAR;
        PG8_STAGE(PG8_SB(1, 0), cB + kstep, voffB); PG8_STAGE(PG8_SA(1, 0), cA + kstep, voffA); PG8_STAGE(PG8_SB(1, 1), cB + hstep + kstep, voffB);
        PG8_WAIT_V(6); PG8_BAR;
    }
    for (;;) {
        const bool has_next = S.next(ui + 1, nxt);
        const char* nA = has_next ? (const char*)g.A + (size_t)nxt.pm * tstep : cA; const char* nB = has_next ? (const char*)g.Bt + (size_t)nxt.pn * tstep : cB;
        for (int t = 0; t < nt; t += 2) {
            const bool last = (t == nt - 2);
            const char* a1 = cA + (size_t)(t + 1) * kstep;
            const char* a2 = last ? nA : cA + (size_t)(t + 2) * kstep; const char* b2 = last ? nB : cB + (size_t)(t + 2) * kstep;
            const char* a3 = a2 + kstep; const char* b3 = b2 + kstep;
            if (last && has_next) S.a_ready(nxt);
            if constexpr (SP2) {
            PG8_LDB(B0, 0, 0); PG8_LDB(B1, 0, 1); PG8_SCHED; PG8_LDA(At, 0, 0); PG8_STAGE(PG8_SA(1, 1), a1 + hstep, voffA);
            PG8_WAIT_V(8); PG8_WAIT_L(0); PG8_BAR; PG8_MMA(0, 0, At, B0); PG8_MMA(0, 1, At, B1); PG8_BAR; PG8_SCHED;
            PG8_LDA(At, 0, 1); PG8_STAGE(PG8_SB(0, 0), b2, voffB); PG8_STAGE(PG8_SB(0, 1), b2 + hstep, voffB); PG8_STAGE(PG8_SA(0, 0), a2, voffA);
            PG8_WAIT_V(8); PG8_WAIT_L(0); PG8_BAR; PG8_MMA(1, 0, At, B0); PG8_MMA(1, 1, At, B1); PG8_BAR; PG8_SCHED;
            PG8_LDB(B0, 1, 0); PG8_LDB(B1, 1, 1); PG8_SCHED; PG8_LDA(At, 1, 0); PG8_STAGE(PG8_SA(0, 1), a2 + hstep, voffA);
            PG8_WAIT_V(8); PG8_WAIT_L(0); PG8_BAR; PG8_MMA(0, 0, At, B0); PG8_MMA(0, 1, At, B1); PG8_BAR; PG8_SCHED;
            PG8_LDA(At, 1, 1); PG8_STAGE(PG8_SB(1, 0), b3, voffB); PG8_STAGE(PG8_SB(1, 1), b3 + hstep, voffB); PG8_STAGE(PG8_SA(1, 0), a3, voffA);
            PG8_WAIT_V(8); PG8_WAIT_L(0); PG8_BAR; PG8_MMA(1, 0, At, B0); PG8_MMA(1, 1, At, B1); PG8_BAR; PG8_SCHED;
            } else {
            PG8_LDB(B0, 0, 0); PG8_SCHED; PG8_LDA(At, 0, 0); PG8_STAGE(PG8_SA(1, 1), a1 + hstep, voffA);
            PG8_WAIT_L(8); PG8_BAR; PG8_WAIT_L(0); PG8_MMA(0, 0, At, B0); PG8_BAR; PG8_SCHED;
            PG8_LDB(B1, 0, 1); PG8_STAGE(PG8_SB(0, 0), b2, voffB);
            PG8_BAR; PG8_WAIT_L(0); PG8_MMA(0, 1, At, B1); PG8_BAR;
            PG8_LDA(At, 0, 1); PG8_STAGE(PG8_SA(0, 0), a2, voffA);
            PG8_BAR; PG8_WAIT_L(0); PG8_MMA(1, 0, At, B0); PG8_BAR; PG8_SCHED;
            PG8_STAGE(PG8_SB(0, 1), b2 + hstep, voffB);
            PG8_WAIT_V(6); PG8_BAR; PG8_MMA(1, 1, At, B1); PG8_BAR;
            PG8_LDB(B0, 1, 0); PG8_SCHED; PG8_LDA(At, 1, 0); PG8_STAGE(PG8_SA(0, 1), a2 + hstep, voffA);
            PG8_WAIT_L(8); PG8_BAR; PG8_WAIT_L(0); PG8_MMA(0, 0, At, B0); PG8_BAR; PG8_SCHED;
            PG8_LDB(B1, 1, 1); PG8_STAGE(PG8_SB(1, 0), b3, voffB);
            PG8_BAR; PG8_WAIT_L(0); PG8_MMA(0, 1, At, B1); PG8_BAR;
            PG8_LDA(At, 1, 1); PG8_STAGE(PG8_SA(1, 0), a3, voffA);
            PG8_BAR; PG8_WAIT_L(0); PG8_MMA(1, 0, At, B0); PG8_BAR; PG8_SCHED;
            PG8_STAGE(PG8_SB(1, 1), b3 + hstep, voffB);
            PG8_WAIT_V(6); PG8_BAR; PG8_MMA(1, 1, At, B1); PG8_BAR;
            }
        }
        if constexpr (ALIGN_EPI) { if (wr == 0) PG8_BAR; }
        if constexpr (!Epi::AFTER_DRAIN) { E(acc, cur, wr, wc, fr, fq); S.done(cur); }
        if (!has_next) break;
#pragma unroll
        for (int a = 0; a < 2; ++a)
#pragma unroll
            for (int b = 0; b < 2; ++b)
#pragma unroll
                for (int m = 0; m < 4; ++m)
#pragma unroll
                    for (int n = 0; n < 2; ++n) acc[a][b][m][n] = (f32x4){0.f, 0.f, 0.f, 0.f};
        cur = nxt; cA = nA; cB = nB; ++ui;
        if constexpr (ALIGN_EPI) { if (wr == 1) PG8_BAR; }
    }
    PG8_WAIT_V(0);
    if constexpr (!ALIGN_EPI) { if (wr == 0) PG8_BAR; }
    PG8_BAR;
    if constexpr (Epi::AFTER_DRAIN) { E.fused(acc, cur, wr, wc, fr, fq, lds, wid, lane); S.done(cur); }
#undef PG8_SA
#undef PG8_SB
#undef PG8_STAGE
#undef PG8_LDA
#undef PG8_LDB
#undef PG8_MMA
#undef PG8_WAIT_V
#undef PG8_WAIT_L
#undef PG8_BAR
#undef PG8_SCHED
}
}

#define LAS __attribute__((address_space(3)))
typedef unsigned short bf16;
typedef float f32x4 __attribute__((ext_vector_type(4)));
typedef short bf16x8 __attribute__((ext_vector_type(8)));
typedef unsigned u32x4 __attribute__((ext_vector_type(4)));

constexpr int DM = 2048, SEQ = 2048, NBP = 4, MP = 8192, MS = 128, MT = 8320, MPAD = 8448;
constexpr int DA = 1024, HA = 16, ASH = 3200, NCPAD = 8448, ZBW = 5248;
constexpr int HB = 4, HDB = 256;
constexpr int ZB_GA = 0, ZB_Q = 1024, ZB_K = 2048, ZB_V = 3072, ZB_G = 4096;
constexpr size_t MiB = 1u << 20;
constexpr size_t WS_CTL = 0, WS_WINT = 1 * MiB, WS_XN = 34 * MiB, WS_GT = 1 * MiB, WS_WOUTT = 67 * MiB, WS_WGT = 75 * MiB, WS_WPLET = 83 * MiB,
                 WS_PB = 84 * MiB, WS_ROT = 89 * MiB, WS_ZA = 92 * MiB, WS_YA = 92 * MiB, WS_MIX = 125 * MiB, WS_ST = 158 * MiB, WS_ZB = 196 * MiB, WS_PLE = 1 * MiB,
                 WS_OPS = 281 * MiB, WS_OPSS = 473 * MiB, WS_H2 = 281 * MiB, WS_H2B = 347 * MiB, WS_KDT = 476 * MiB, WS_VT = 492 * MiB, WS_RSS = 508 * MiB, WS_END = 509 * MiB;
constexpr size_t O_Y = 0, O_WKVP = 17039360, O_SHP = 17301504, O_RETP = 17314304, O_WKVS = 18362880, O_SHS = 26751488, O_RETS = 27161088;
constexpr int LDS_BYTES = 135168;

struct Params { const float* in[25]; float* out; unsigned char* ws; int ph_lo, ph_hi; };
enum { I_XP = 0, I_XS, I_PP, I_PS, I_SWKV, I_SSHIFT, I_SRET, I_GLN, I_WIN, I_MU, I_W0, I_WWB, I_A0, I_WAB, I_KK, I_KA, I_RK, I_GAG, I_GAB, I_GBG, I_GBB, I_WOUT, I_WPLE, I_WGATE, I_GFIN };

__device__ __forceinline__ unsigned f2bf(float f) { unsigned u = __builtin_bit_cast(unsigned, f); return (u + 0x7fffu + ((u >> 16) & 1u)) >> 16; }
__device__ __forceinline__ unsigned pk2(float lo, float hi) { return f2bf(lo) | (f2bf(hi) << 16); }
__device__ __forceinline__ float bf2f(unsigned h) { return __builtin_bit_cast(float, h << 16); }
__device__ __forceinline__ float bflo(unsigned w) { return __builtin_bit_cast(float, w << 16); }
__device__ __forceinline__ float bfhi(unsigned w) { return __builtin_bit_cast(float, w & 0xffff0000u); }
__device__ __forceinline__ float wave_sum(float v) {
#pragma unroll
    for (int o = 1; o < 64; o <<= 1) v += __shfl_xor(v, o);
    return v;
}
__device__ __forceinline__ float sigmoidf_(float x) { return 1.f / (1.f + __expf(-x)); }
__device__ __forceinline__ float siluf_(float x) { return x / (1.f + __expf(-x)); }
__device__ __forceinline__ float gamma_h(int h) { return 1.f - exp2f(-5.f - (float)h); }
__device__ __forceinline__ float gpow(int h, float n) { return (float)exp((double)n * log(1.0 - exp2(-5.0 - (double)h))); }

__device__ __forceinline__ void p0_transpose_item(const float* W, int K, int N, bf16* WT, LAS float* scr, int item, int lane) {
    const int nblk = N / 32, kb = item / nblk, nb = item % nblk, k0 = 64 * kb, n0 = 32 * nb;
#pragma unroll 8
    for (int i = 0; i < 32; ++i) { const int kk = 2 * i + (lane >> 5); scr[kk * 33 + (lane & 31)] = W[(size_t)(k0 + kk) * N + n0 + (lane & 31)]; }
    asm volatile("s_waitcnt lgkmcnt(0)" ::: "memory");
    const int c = lane & 7;
#pragma unroll
    for (int j = 0; j < 4; ++j) { const int n = (lane >> 3) + 8 * j; const LAS float* s = scr + (8 * c) * 33 + n;
        u32x4 o; o.x = pk2(s[0 * 33], s[1 * 33]); o.y = pk2(s[2 * 33], s[3 * 33]); o.z = pk2(s[4 * 33], s[5 * 33]); o.w = pk2(s[6 * 33], s[7 * 33]);
        *(u32x4*)(WT + (size_t)(n0 + n) * K + k0 + 8 * c) = o; }
    asm volatile("s_waitcnt lgkmcnt(0)" ::: "memory");
}

__device__ __forceinline__ void phase0(const Params& p, LAS unsigned char* lds) {
    const int tid = threadIdx.x, lane = tid & 63, wave = tid >> 6;
    const int gw = blockIdx.x * 8 + wave, NGW = gridDim.x * 8;
    unsigned char* ws = p.ws;
    LAS float* scr = (LAS float*)(lds + wave * 16384);
    constexpr int I_IN = 32 * 260, I_O = 32 * 64, I_G = 32 * 64, I_P = 4 * 64, NIT = I_IN + I_O + I_G + I_P;
    for (int it = gw; it < NIT; it += NGW) {
        int r = it;
        if (r < I_IN) { p0_transpose_item(p.in[I_WIN], 2048, 8320, (bf16*)(ws + WS_WINT), scr, r, lane); continue; } r -= I_IN;
        if (r < I_O) { p0_transpose_item(p.in[I_WOUT], 2048, 2048, (bf16*)(ws + WS_WOUTT), scr, r, lane); continue; } r -= I_O;
        if (r < I_G) { p0_transpose_item(p.in[I_WGATE], 2048, 2048, (bf16*)(ws + WS_WGT), scr, r, lane); continue; } r -= I_G;
        p0_transpose_item(p.in[I_WPLE], 256, 2048, (bf16*)(ws + WS_WPLET), scr, r, lane);
    }
    const float* g = p.in[I_GLN];
    for (int row = gw; row < MT; row += NGW) {
        const float* xr = row < MP ? p.in[I_XP] + (size_t)row * DM : p.in[I_XS] + (size_t)(row - MP) * DM;
        f32x4 v[8]; float s = 0.f;
#pragma unroll
        for (int j = 0; j < 8; ++j) { v[j] = ((const f32x4*)xr)[lane + 64 * j]; s += (v[j].x * v[j].x + v[j].y * v[j].y) + (v[j].z * v[j].z + v[j].w * v[j].w); }
        const float rstd = 1.f / sqrtf(wave_sum(s) * (1.f / DM) + 1e-6f);
        unsigned long long* o8 = (unsigned long long*)((bf16*)(ws + WS_XN) + (size_t)row * DM);
#pragma unroll
        for (int j = 0; j < 8; ++j) { const f32x4 gg = ((const f32x4*)g)[lane + 64 * j];
            o8[lane + 64 * j] = (unsigned long long)pk2(v[j].x * rstd * gg.x, v[j].y * rstd * gg.y) | ((unsigned long long)pk2(v[j].z * rstd * gg.z, v[j].w * rstd * gg.w) << 32); }
    }
    for (int row = gw; row < MT; row += NGW) {
        const float* pr = row < MP ? p.in[I_PP] + (size_t)row * 256 : p.in[I_PS] + (size_t)(row - MP) * 256;
        const f32x4 v = ((const f32x4*)pr)[lane];
        ((unsigned long long*)((bf16*)(ws + WS_PB) + (size_t)row * 256))[lane] = (unsigned long long)pk2(v.x, v.y) | ((unsigned long long)pk2(v.z, v.w) << 32);
    }
    {
        float2* tab = (float2*)(ws + WS_ROT);
        const int gt = blockIdx.x * 512 + tid, NT = gridDim.x * 512;
        for (int e = gt; e < 2049 * 128; e += NT) {
            const int pi = e >> 7, i = e & 127;
            const float pos = pi < 2048 ? (float)pi : 16384.f;
            const float lin = (float)i / 127.f;
            const float angle = 1.0f / powf(10000.f, lin);
            const float theta = pos * angle;
            tab[e] = make_float2((float)cos((double)theta), (float)sin((double)theta));
        }
        float* rss = (float*)(ws + WS_RSS);
        for (int e = gt; e < MPAD; e += NT) rss[e] = 0.f;
    }
}

struct Epi1 {
    static constexpr bool PERM = true, AFTER_DRAIN = false;
    float* ZA; bf16* ZB; const float2* rot;
    __device__ __forceinline__ void operator()(const pg8::f32x4 (&acc)[2][2][4][2], const pg8::Unit& u, int wr, int wc, int fr, int fq) const {
#pragma unroll
        for (int ai = 0; ai < 2; ++ai)
#pragma unroll
            for (int m = 0; m < 4; ++m) {
                const int row = u.pm * 256 + ai * 128 + wr * 64 + m * 16 + fr;
                if (row >= MT) continue;
                const int pidx = row < MP ? (row & 2047) : 2048;
#pragma unroll
                for (int bj = 0; bj < 2; ++bj) {
                    const int c0 = u.pn * 256 + bj * 128 + wc * 32 + 8 * fq;
                    if (c0 >= 8320) continue;
                    pg8::f32x4 v0 = acc[ai][bj][m][0], v1 = acc[ai][bj][m][1];
                    if (c0 < ASH) { float* d = ZA + (size_t)row * ASH + c0; *(pg8::f32x4*)d = v0; *(pg8::f32x4*)(d + 4) = v1; }
                    else {
                        if (c0 >= 4224 && c0 < 6272) {
                            const int dl = (c0 - 4224) & 255;
                            const float2* t = rot + (size_t)pidx * 128 + (dl >> 1);
                            const float sc = c0 >= 5248 ? 0.0625f : 1.f;
                            const float2 t0 = t[0], t1 = t[1], t2 = t[2], t3 = t[3];
                            pg8::f32x4 r0, r1;
                            r0.x = (v0.x * t0.x - v0.y * t0.y) * sc; r0.y = (v0.x * t0.y + v0.y * t0.x) * sc;
                            r0.z = (v0.z * t1.x - v0.w * t1.y) * sc; r0.w = (v0.z * t1.y + v0.w * t1.x) * sc;
                            r1.x = (v1.x * t2.x - v1.y * t2.y) * sc; r1.y = (v1.x * t2.y + v1.y * t2.x) * sc;
                            r1.z = (v1.z * t3.x - v1.w * t3.y) * sc; r1.w = (v1.z * t3.y + v1.w * t3.x) * sc;
                            v0 = r0; v1 = r1;
                        }
                        u32x4 w; w.x = pk2(v0.x, v0.y); w.y = pk2(v0.z, v0.w); w.z = pk2(v1.x, v1.y); w.w = pk2(v1.z, v1.w);
                        *(u32x4*)(ZB + (size_t)row * ZBW + (c0 - ASH)) = w;
                    }
                }
            }
    }
};
struct EpiPle {
    static constexpr bool PERM = true, AFTER_DRAIN = false;
    bf16* O;
    __device__ __forceinline__ void operator()(const pg8::f32x4 (&acc)[2][2][4][2], const pg8::Unit& u, int wr, int wc, int fr, int fq) const {
#pragma unroll
        for (int ai = 0; ai < 2; ++ai)
#pragma unroll
            for (int m = 0; m < 4; ++m) {
                const int row = u.pm * 256 + ai * 128 + wr * 64 + m * 16 + fr;
#pragma unroll
                for (int bj = 0; bj < 2; ++bj) {
                    const int c0 = u.pn * 256 + bj * 128 + wc * 32 + 8 * fq;
                    const pg8::f32x4 v0 = acc[ai][bj][m][0], v1 = acc[ai][bj][m][1];
                    u32x4 w; w.x = pk2(v0.x, v0.y); w.y = pk2(v0.z, v0.w); w.z = pk2(v1.x, v1.y); w.w = pk2(v1.z, v1.w);
                    *(u32x4*)(O + (size_t)row * DM + c0) = w;
                }
            }
    }
};
struct Epi2 {
    static constexpr bool PERM = true, AFTER_DRAIN = false;
    const float* xp; const float* xs; float* H2; bf16* H2B;
    __device__ __forceinline__ void operator()(const pg8::f32x4 (&acc)[2][2][4][2], const pg8::Unit& u, int wr, int wc, int fr, int fq) const {
#pragma unroll
        for (int ai = 0; ai < 2; ++ai)
#pragma unroll
            for (int m = 0; m < 4; ++m) {
                const int row = u.pm * 256 + ai * 128 + wr * 64 + m * 16 + fr;
                if (row >= MT) continue;
                const float* xr = row < MP ? xp + (size_t)row * DM : xs + (size_t)(row - MP) * DM;
#pragma unroll
                for (int bj = 0; bj < 2; ++bj) {
                    const int c0 = u.pn * 256 + bj * 128 + wc * 32 + 8 * fq;
                    const pg8::f32x4 v0 = acc[ai][bj][m][0] + *(const pg8::f32x4*)(xr + c0), v1 = acc[ai][bj][m][1] + *(const pg8::f32x4*)(xr + c0 + 4);
                    float* d = H2 + (size_t)row * DM + c0; *(pg8::f32x4*)d = v0; *(pg8::f32x4*)(d + 4) = v1;
                    u32x4 w; w.x = pk2(v0.x, v0.y); w.y = pk2(v0.z, v0.w); w.z = pk2(v1.x, v1.y); w.w = pk2(v1.z, v1.w);
                    *(u32x4*)(H2B + (size_t)row * DM + c0) = w;
                }
            }
    }
};
struct Epi3 {
    static constexpr bool PERM = true, AFTER_DRAIN = false;
    const float* H2; const bf16* PLE; float* out; float* rss;
    __device__ __forceinline__ void operator()(const pg8::f32x4 (&acc)[2][2][4][2], const pg8::Unit& u, int wr, int wc, int fr, int fq) const {
#pragma unroll
        for (int ai = 0; ai < 2; ++ai)
#pragma unroll
            for (int m = 0; m < 4; ++m) {
                const int row = u.pm * 256 + ai * 128 + wr * 64 + m * 16 + fr;
                const bool ok = row < MT;
                float ss = 0.f;
#pragma unroll
                for (int bj = 0; bj < 2; ++bj) {
                    const int c0 = u.pn * 256 + bj * 128 + wc * 32 + 8 * fq;
                    if (ok) {
                        const pg8::f32x4 a0 = acc[ai][bj][m][0], a1 = acc[ai][bj][m][1];
                        const pg8::f32x4 h0 = *(const pg8::f32x4*)(H2 + (size_t)row * DM + c0), h1 = *(const pg8::f32x4*)(H2 + (size_t)row * DM + c0 + 4);
                        const u32x4 pw = *(const u32x4*)(PLE + (size_t)row * DM + c0);
                        pg8::f32x4 o0, o1;
                        o0.x = h0.x + sigmoidf_(a0.x) * bflo(pw.x); o0.y = h0.y + sigmoidf_(a0.y) * bfhi(pw.x);
                        o0.z = h0.z + sigmoidf_(a0.z) * bflo(pw.y); o0.w = h0.w + sigmoidf_(a0.w) * bfhi(pw.y);
                        o1.x = h1.x + sigmoidf_(a1.x) * bflo(pw.z); o1.y = h1.y + sigmoidf_(a1.y) * bfhi(pw.z);
                        o1.z = h1.z + sigmoidf_(a1.z) * bflo(pw.w); o1.w = h1.w + sigmoidf_(a1.w) * bfhi(pw.w);
                        float* d = out + (size_t)row * DM + c0; *(pg8::f32x4*)d = o0; *(pg8::f32x4*)(d + 4) = o1;
                        ss += (o0.x * o0.x + o0.y * o0.y) + (o0.z * o0.z + o0.w * o0.w) + (o1.x * o1.x + o1.y * o1.y) + (o1.z * o1.z + o1.w * o1.w);
                    }
                }
                ss += __shfl_xor(ss, 16); ss += __shfl_xor(ss, 32);
                if (ok && fq == 0) atomicAdd(rss + row, ss);
            }
    }
};

__device__ __forceinline__ float za_prev(const Params& p, const float* ZA, int row, int col) {
    if (row < MP) return (row & 2047) ? ZA[(size_t)(row - 1) * ASH + col] : 0.f;
    return p.in[I_SSHIFT][(size_t)(row - MP) * ASH + col];
}
__device__ __forceinline__ float za_xs(const Params& p, const float* ZA, int row, int col) {
    const float f = ZA[(size_t)row * ASH + col];
    return f + p.in[I_MU][col] * (za_prev(p, ZA, row, col) - f);
}
__device__ __forceinline__ void prep_item(const Params& p, int item, LAS unsigned char* lds) {
    const int tid = threadIdx.x;
    const int tile = item >> 4, h = item & 15, row0 = tile * 64;
    const float* ZA = (const float*)(p.ws + WS_ZA);
    LAS float* xw = (LAS float*)lds; LAS float* xa = xw + 4096;
    for (int e = tid; e < 64 * 128; e += 512) {
        const int tok = e >> 7, j = e & 127;
        const float xs = za_xs(p, ZA, row0 + tok, 3072 + j);
        if (j < 64) xw[tok * 64 + j] = tanhf(xs); else xa[tok * 64 + j - 64] = xs;
    }
    __syncthreads();
    const int c = tid & 63, tg = tid >> 6, ch = h * 64 + c;
    float aw[8], aa[8];
#pragma unroll
    for (int i = 0; i < 8; ++i) { aw[i] = 0.f; aa[i] = 0.f; }
    const float* wwB = p.in[I_WWB] + ch; const float* waB = p.in[I_WAB] + ch;
#pragma unroll 4
    for (int j = 0; j < 64; ++j) {
        const float ww = wwB[(size_t)j * DA], wa = waB[(size_t)j * DA];
#pragma unroll
        for (int i = 0; i < 8; ++i) { aw[i] += xw[(tg * 8 + i) * 64 + j] * ww; aa[i] += xa[(tg * 8 + i) * 64 + j] * wa; }
    }
    const float w0 = p.in[I_W0][ch], a0 = p.in[I_A0][ch], kkw = p.in[I_KK][ch], kaw = p.in[I_KA][ch];
#pragma unroll
    for (int i = 0; i < 8; ++i) {
        const int row = row0 + tg * 8 + i;
        const float r = za_xs(p, ZA, row, ch), k = za_xs(p, ZA, row, 1024 + ch), v = za_xs(p, ZA, row, 2048 + ch);
        const float lw = w0 + aw[i];
        const float nx = -lw;
        const float sp = fmaxf(nx, 0.f) + log1pf(expf(-fabsf(nx)));
        const float decay = expf(-expf(-sp - 0.5f));
        const float a = 1.f / (1.f + expf(-(a0 + aa[i])));
        float kk = k * kkw;
        const float nrm = fmaxf(sqrtf(wave_sum(kk * kk)), 1e-12f);
        kk = kk / nrm;
        const float k2 = k * (1.f + (a - 1.f) * kaw);
        float* base = row < MP ? (float*)(p.ws + WS_OPS) + ((size_t)((row >> 11) * 16 + h) * 2048 + (row & 2047)) * 384
                               : (float*)(p.ws + WS_OPSS) + ((size_t)(row - MP) * 16 + h) * 384;
        base[c] = decay; base[64 + c] = -kk; base[128 + c] = kk * a; base[192 + c] = k2; base[256 + c] = r; base[320 + c] = v;
    }
    __syncthreads();
}
__device__ __forceinline__ void tr_item(const Params& p, int item, LAS unsigned char* lds) {
    const int tid = threadIdx.x;
    const int which = item & 1, tt = (item >> 1) & 31, bh = item >> 6, b = bh >> 2, h = bh & 3;
    const bf16* ZB = (const bf16*)(p.ws + WS_ZB);
    LAS bf16* tile = (LAS bf16*)lds;
    const int t0 = tt * 64;
    const float lg = logf(gamma_h(h));
    for (int e = tid; e < 2048; e += 512) {
        const int t = e >> 5, dc = e & 31;
        const u32x4 w = *(const u32x4*)(ZB + (size_t)(b * 2048 + t0 + t) * ZBW + (which ? ZB_V : ZB_K) + h * 256 + dc * 8);
        unsigned ww[4] = {w.x, w.y, w.z, w.w};
        float sc = 1.f;
        if (!which) sc = expf((float)(127 - ((t0 + t) & 127)) * lg);
#pragma unroll
        for (int i = 0; i < 4; ++i) {
            tile[t * 258 + dc * 8 + 2 * i] = (bf16)f2bf(bflo(ww[i]) * sc);
            tile[t * 258 + dc * 8 + 2 * i + 1] = (bf16)f2bf(bfhi(ww[i]) * sc);
        }
    }
    __syncthreads();
    bf16* dst = (bf16*)(p.ws + (which ? WS_VT : WS_KDT)) + (size_t)bh * 256 * 2048;
    for (int e = tid; e < 2048; e += 512) {
        const int d = e >> 3, tc = e & 7;
        unsigned o[4];
#pragma unroll
        for (int i = 0; i < 4; ++i) o[i] = (unsigned)tile[(tc * 8 + 2 * i) * 258 + d] | ((unsigned)tile[(tc * 8 + 2 * i + 1) * 258 + d] << 16);
        u32x4 w; w.x = o[0]; w.y = o[1]; w.z = o[2]; w.w = o[3];
        *(u32x4*)(dst + (size_t)d * 2048 + t0 + tc * 8) = w;
    }
    __syncthreads();
}
__device__ __forceinline__ void phase2(const Params& p, LAS unsigned char* lds) {
    for (int it = blockIdx.x; it < 130 * 16; it += gridDim.x) prep_item(p, it, lds);
    for (int it = blockIdx.x; it < 1024; it += gridDim.x) tr_item(p, it, lds);
    const float* ZA = (const float*)(p.ws + WS_ZA);
    const int gt = blockIdx.x * 512 + threadIdx.x, NT = gridDim.x * 512;
    for (int e = gt; e < 4 * ASH; e += NT) { const int b = e / ASH, c = e % ASH; p.out[O_SHP + e] = ZA[(size_t)(b * 2048 + 2047) * ASH + c]; }
    for (int e = gt; e < MS * ASH; e += NT) { p.out[O_SHS + e] = ZA[(size_t)MP * ASH + e]; }
}

__device__ __forceinline__ void scan_unit(const Params& p, int unit, LAS unsigned char* lds) {
    const int tid = threadIdx.x, wave = tid >> 6, lane = tid & 63;
    const int bh = (unit & 7) * 8 + ((unit >> 3) >> 2), rg = (unit >> 3) & 3, b = bh >> 4, h = bh & 15;
    const float* ops = (const float*)(p.ws + WS_OPS) + (size_t)bh * 2048 * 384;
    float* YA = (float*)(p.ws + WS_YA);
    LAS float* buf = (LAS float*)lds;
    const int r = lane >> 3, q = lane & 7, rowl = rg * 16 + (wave & 1) * 8 + r;
    float S[8];
#pragma unroll
    for (int j = 0; j < 8; ++j) S[j] = 0.f;
    for (int e = tid; e < 3072; e += 512) ((LAS f32x4*)buf)[e] = ((const f32x4*)ops)[e];
    __syncthreads();
    for (int ck = 0; ck < 64; ++ck) {
        LAS float* cur = buf + (ck & 1) * 12288; LAS float* nxt = buf + ((ck + 1) & 1) * 12288;
        if (wave >= 2) {
            if (ck + 1 < 64) {
                const f32x4* src = (const f32x4*)(ops + (size_t)(ck + 1) * 12288);
#pragma unroll
                for (int i = 0; i < 8; ++i) { const int e = (tid - 128) + i * 384; ((LAS f32x4*)nxt)[e] = src[e]; }
            }
        } else {
            for (int t = 0; t < 32; ++t) {
                LAS const float* o = cur + t * 384;
                const f32x4 w0 = *(LAS const f32x4*)(o + q * 8), w1 = *(LAS const f32x4*)(o + q * 8 + 4);
                const f32x4 a0 = *(LAS const f32x4*)(o + 64 + q * 8), a1 = *(LAS const f32x4*)(o + 64 + q * 8 + 4);
                const f32x4 b0 = *(LAS const f32x4*)(o + 128 + q * 8), b1 = *(LAS const f32x4*)(o + 128 + q * 8 + 4);
                const f32x4 k0 = *(LAS const f32x4*)(o + 192 + q * 8), k1 = *(LAS const f32x4*)(o + 192 + q * 8 + 4);
                const f32x4 r0 = *(LAS const f32x4*)(o + 256 + q * 8), r1 = *(LAS const f32x4*)(o + 256 + q * 8 + 4);
                const float vv = o[320 + rowl];
                float dot = (S[0] * a0.x + S[1] * a0.y) + (S[2] * a0.z + S[3] * a0.w) + (S[4] * a1.x + S[5] * a1.y) + (S[6] * a1.z + S[7] * a1.w);
                dot += __shfl_xor(dot, 1); dot += __shfl_xor(dot, 2); dot += __shfl_xor(dot, 4);
                S[0] = S[0] * w0.x + dot * b0.x + vv * k0.x; S[1] = S[1] * w0.y + dot * b0.y + vv * k0.y;
                S[2] = S[2] * w0.z + dot * b0.z + vv * k0.z; S[3] = S[3] * w0.w + dot * b0.w + vv * k0.w;
                S[4] = S[4] * w1.x + dot * b1.x + vv * k1.x; S[5] = S[5] * w1.y + dot * b1.y + vv * k1.y;
                S[6] = S[6] * w1.z + dot * b1.z + vv * k1.z; S[7] = S[7] * w1.w + dot * b1.w + vv * k1.w;
                float y = (S[0] * r0.x + S[1] * r0.y) + (S[2] * r0.z + S[3] * r0.w) + (S[4] * r1.x + S[5] * r1.y) + (S[6] * r1.z + S[7] * r1.w);
                y += __shfl_xor(y, 1); y += __shfl_xor(y, 2); y += __shfl_xor(y, 4);
                if (q == 0) YA[(size_t)(b * 2048 + ck * 32 + t) * DA + h * 64 + rowl] = y;
            }
        }
        __syncthreads();
    }
    if (wave < 2) {
        float* d = p.out + O_WKVP + ((size_t)bh * 64 + rowl) * 64 + q * 8;
        *(f32x4*)d = (f32x4){S[0], S[1], S[2], S[3]}; *(f32x4*)(d + 4) = (f32x4){S[4], S[5], S[6], S[7]};
    }
}
__device__ __forceinline__ void stepA_unit(const Params& p, int unit) {
    const int tid = threadIdx.x, wave = tid >> 6, lane = tid & 63, fr = lane & 15, fq = lane >> 4;
    const int bh = unit >> 4, c = unit & 15;
    const bf16* VT = (const bf16*)(p.ws + WS_VT) + (size_t)bh * 256 * 2048 + c * 128;
    const bf16* KT = (const bf16*)(p.ws + WS_KDT) + (size_t)bh * 256 * 2048 + c * 128;
    float* GT = (float*)(p.ws + WS_GT) + (size_t)unit * 65536;
#pragma unroll 1
    for (int nh = 0; nh < 2; ++nh) {
        f32x4 acc[2][8];
#pragma unroll
        for (int m = 0; m < 2; ++m)
#pragma unroll
            for (int n = 0; n < 8; ++n) acc[m][n] = (f32x4){0.f, 0.f, 0.f, 0.f};
#pragma unroll 1
        for (int ks = 0; ks < 4; ++ks) {
            bf16x8 A[2], B[8];
#pragma unroll
            for (int m = 0; m < 2; ++m) A[m] = *(const bf16x8*)(VT + (size_t)(wave * 32 + m * 16 + fr) * 2048 + ks * 32 + fq * 8);
#pragma unroll
            for (int n = 0; n < 8; ++n) B[n] = *(const bf16x8*)(KT + (size_t)(nh * 128 + n * 16 + fr) * 2048 + ks * 32 + fq * 8);
#pragma unroll
            for (int n = 0; n < 8; ++n)
#pragma unroll
                for (int m = 0; m < 2; ++m) acc[m][n] = __builtin_amdgcn_mfma_f32_16x16x32_bf16(A[m], B[n], acc[m][n], 0, 0, 0);
        }
#pragma unroll
        for (int m = 0; m < 2; ++m)
#pragma unroll
            for (int n = 0; n < 8; ++n)
#pragma unroll
                for (int r = 0; r < 4; ++r) GT[(size_t)(wave * 32 + m * 16 + fq * 4 + r) * 256 + nh * 128 + n * 16 + fr] = acc[m][n][r];
    }
}
__device__ __forceinline__ void wkv_sample_unit(const Params& p, int su, int lane) {
    const float* o = (const float*)(p.ws + WS_OPSS) + (size_t)su * 384;
    const float* S0 = p.in[I_SWKV] + ((size_t)su * 64 + lane) * 64;
    f32x4 S[16];
#pragma unroll
    for (int j = 0; j < 16; ++j) S[j] = ((const f32x4*)S0)[j];
    float d0 = 0.f, d1 = 0.f;
#pragma unroll
    for (int j = 0; j < 16; ++j) { const f32x4 a = ((const f32x4*)(o + 64))[j]; d0 += S[j].x * a.x + S[j].y * a.y; d1 += S[j].z * a.z + S[j].w * a.w; }
    const float dot = d0 + d1, vv = o[320 + lane];
    float y0 = 0.f, y1 = 0.f;
    float* Sn = p.out + O_WKVS + ((size_t)su * 64 + lane) * 64;
#pragma unroll
    for (int j = 0; j < 16; ++j) {
        const f32x4 w = ((const f32x4*)o)[j], bb = ((const f32x4*)(o + 128))[j], kk = ((const f32x4*)(o + 192))[j], rr = ((const f32x4*)(o + 256))[j];
        f32x4 s = S[j] * w + bb * dot + kk * vv;
        ((f32x4*)Sn)[j] = s;
        y0 += s.x * rr.x + s.y * rr.y; y1 += s.z * rr.z + s.w * rr.w;
    }
    const int s = su >> 4, h = su & 15;
    ((float*)(p.ws + WS_YA))[(size_t)(MP + s) * DA + h * 64 + lane] = y0 + y1;
}
__device__ __forceinline__ void ret_sample_unit(const Params& p, int su, LAS unsigned char* lds) {
    const int tid = threadIdx.x, wave = tid >> 6, lane = tid & 63;
    const int s = su >> 2, h = su & 3, row = MP + s;
    const bf16* zr = (const bf16*)(p.ws + WS_ZB) + (size_t)row * ZBW;
    LAS float* qs = (LAS float*)lds; LAS float* ks = qs + 256; LAS float* red = ks + 256;
    LAS float* st = red + 2048;
    if (tid < 256) { qs[tid] = bf2f(zr[ZB_Q + h * 256 + tid]); ks[tid] = bf2f(zr[ZB_K + h * 256 + tid]); }
    __syncthreads();
    float qk = 0.f;
#pragma unroll
    for (int j = 0; j < 4; ++j) qk += qs[lane * 4 + j] * ks[lane * 4 + j];
    qk = wave_sum(qk);
    const float gam = gamma_h(h);
    const int vq = lane, dp = wave;
    f32x4 vv; { const bf16* vp = zr + ZB_V + h * 256 + vq * 4; vv = (f32x4){bf2f(vp[0]), bf2f(vp[1]), bf2f(vp[2]), bf2f(vp[3])}; }
    const float* S0 = p.in[I_SRET] + (size_t)su * 65536; float* Sn = p.out + O_RETS + (size_t)su * 65536;
    f32x4 acc = (f32x4){0.f, 0.f, 0.f, 0.f};
#pragma unroll 4
    for (int i = 0; i < 32; ++i) {
        const int d = dp * 32 + i;
        const f32x4 s4 = ((const f32x4*)(S0 + (size_t)d * 256))[vq];
        acc += s4 * qs[d];
        ((f32x4*)(Sn + (size_t)d * 256))[vq] = s4 * gam + vv * ks[d];
    }
    *(LAS f32x4*)(red + dp * 256 + vq * 4) = acc;
    __syncthreads();
    float o = 0.f;
    if (tid < 256) {
        float sm = 0.f;
#pragma unroll
        for (int j = 0; j < 8; ++j) sm += red[j * 256 + tid];
        o = qk * bf2f(zr[ZB_V + h * 256 + tid]) + gam * sm;
        const float s1 = wave_sum(o), s2 = wave_sum(o * o);
        if (lane == 0) { st[wave * 2] = s1; st[wave * 2 + 1] = s2; }
    }
    __syncthreads();
    if (tid < 256) {
        const float s1 = st[0] + st[2] + st[4] + st[6], s2 = st[1] + st[3] + st[5] + st[7];
        const float mean = s1 * (1.f / 256.f), var = fmaxf(s2 * (1.f / 256.f) - mean * mean, 0.f);
        const float yn = (o - mean) / sqrtf(var + 1e-5f) * p.in[I_GBG][h * 256 + tid] + p.in[I_GBB][h * 256 + tid];
        const float g = bf2f(zr[ZB_G + h * 256 + tid]);
        ((bf16*)(p.ws + WS_MIX))[(size_t)row * DM + DA + h * 256 + tid] = (bf16)f2bf(yn * siluf_(g));
    }
    __syncthreads();
}
__device__ __forceinline__ void phase3(const Params& p, LAS unsigned char* lds) {
#ifndef SK1
    for (int u = blockIdx.x; u < 256; u += gridDim.x) scan_unit(p, u, lds);
#endif
#ifndef SK2
    for (int u = blockIdx.x; u < 256; u += gridDim.x) stepA_unit(p, u);
#endif
    const int gw = blockIdx.x * 8 + (threadIdx.x >> 6), NGW = gridDim.x * 8;
#ifndef SK3
    for (int u = gw; u < MS * 16; u += NGW) wkv_sample_unit(p, u, threadIdx.x & 63);
#endif
#ifndef SK4
    for (int u = blockIdx.x; u < MS * 4; u += gridDim.x) ret_sample_unit(p, u, lds);
#endif
}

__device__ __forceinline__ void phase4(const Params& p) {
    const int gt = blockIdx.x * 512 + threadIdx.x, NT = gridDim.x * 512;
    const float* GT = (const float*)(p.ws + WS_GT); bf16* ST = (bf16*)(p.ws + WS_ST);
    for (int e = gt; e < 16 * 65536; e += NT) {
        const int bh = e >> 16, vd = e & 65535, v = vd >> 8, d = vd & 255, h = bh & 3;
        const float g128 = gpow(h, 128.f);
        float S = 0.f;
        for (int c = 0; c < 16; ++c) {
            ST[((size_t)(bh * 16 + c) << 16) + vd] = (bf16)f2bf(S);
            S = S * g128 + GT[((size_t)(bh * 16 + c) << 16) + vd];
        }
        p.out[O_RETP + ((size_t)bh << 16) + d * 256 + v] = S;
    }
    const int gw = blockIdx.x * 8 + (threadIdx.x >> 6), NGW = gridDim.x * 8, lane = threadIdx.x & 63;
    const float* YA = (const float*)(p.ws + WS_YA); const bf16* ZB = (const bf16*)(p.ws + WS_ZB); bf16* MIX = (bf16*)(p.ws + WS_MIX);
    for (int u = gw; u < MT * 16; u += NGW) {
        const int row = u >> 4, h = u & 15, ch = h * 64 + lane;
        const float y = YA[(size_t)row * DA + ch];
        const float mean = wave_sum(y) * (1.f / 64.f), yc = y - mean, var = wave_sum(yc * yc) * (1.f / 64.f);
        const float* base = row < MP ? (const float*)(p.ws + WS_OPS) + ((size_t)((row >> 11) * 16 + h) * 2048 + (row & 2047)) * 384
                                     : (const float*)(p.ws + WS_OPSS) + ((size_t)(row - MP) * 16 + h) * 384;
        const float r = base[256 + lane], k2 = base[192 + lane], v = base[320 + lane];
        const float bonus = wave_sum(r * k2 * p.in[I_RK][ch]) * v;
        const float yn = yc / sqrtf(var + 64e-5f) * p.in[I_GAG][ch] + p.in[I_GAB][ch] + bonus;
        const float g = bf2f(ZB[(size_t)row * ZBW + ZB_GA + ch]);
        MIX[(size_t)row * DM + ch] = (bf16)f2bf(yn * siluf_(g));
    }
}

__device__ __forceinline__ void stepC_unit(const Params& p, int unit, LAS unsigned char* lds) {
    const int tid = threadIdx.x, wave = tid >> 6, lane = tid & 63, fr = lane & 15, fq = lane >> 4;
    const int bh = unit >> 4, c = unit & 15, b = bh >> 2, h = bh & 3, wr = wave >> 1, wc = wave & 1;
    const int rowb = b * 2048 + c * 128;
    const bf16* ZB = (const bf16*)(p.ws + WS_ZB);
    const bf16* Q = ZB + (size_t)rowb * ZBW + ZB_Q + h * 256;
    const bf16* Kp = ZB + (size_t)rowb * ZBW + ZB_K + h * 256;
    const bf16* VT = (const bf16*)(p.ws + WS_VT) + (size_t)bh * 256 * 2048 + c * 128;
    const bf16* ST = (const bf16*)(p.ws + WS_ST) + ((size_t)(bh * 16 + c) << 16);
    LAS bf16* Pl = (LAS bf16*)lds;
    LAS bf16* Qs = Pl + 128 * 136;
    LAS float* red = (LAS float*)(lds + 110592);
    const float lg = logf(gamma_h(h));
    for (int e = tid; e < 4096; e += 512) {
        const int i = e >> 5, dc = e & 31;
        const u32x4 w = *(const u32x4*)(Q + (size_t)i * ZBW + dc * 8);
        const float sc = expf((float)(i + 1) * lg);
        u32x4 o; o.x = pk2(bflo(w.x) * sc, bfhi(w.x) * sc); o.y = pk2(bflo(w.y) * sc, bfhi(w.y) * sc); o.z = pk2(bflo(w.z) * sc, bfhi(w.z) * sc); o.w = pk2(bflo(w.w) * sc, bfhi(w.w) * sc);
        *(LAS u32x4*)(Qs + i * 264 + dc * 8) = o;
    }
    {
        f32x4 sa[2][4];
#pragma unroll
        for (int m = 0; m < 2; ++m)
#pragma unroll
            for (int n = 0; n < 4; ++n) sa[m][n] = (f32x4){0.f, 0.f, 0.f, 0.f};
        for (int ks = 0; ks < 8; ++ks) {
            bf16x8 A[2];
#pragma unroll
            for (int m = 0; m < 2; ++m) A[m] = *(const bf16x8*)(Q + (size_t)(wr * 32 + m * 16 + fr) * ZBW + ks * 32 + fq * 8);
#pragma unroll
            for (int n = 0; n < 4; ++n) {
                const bf16x8 B = *(const bf16x8*)(Kp + (size_t)(wc * 64 + n * 16 + fr) * ZBW + ks * 32 + fq * 8);
#pragma unroll
                for (int m = 0; m < 2; ++m) sa[m][n] = __builtin_amdgcn_mfma_f32_16x16x32_bf16(A[m], B, sa[m][n], 0, 0, 0);
            }
        }
#pragma unroll
        for (int m = 0; m < 2; ++m)
#pragma unroll
            for (int n = 0; n < 4; ++n)
#pragma unroll
                for (int r = 0; r < 4; ++r) {
                    const int i = wr * 32 + m * 16 + fq * 4 + r, j = wc * 64 + n * 16 + fr;
                    const float v = i >= j ? sa[m][n][r] * expf((float)(i - j) * lg) : 0.f;
                    Pl[i * 136 + j] = (bf16)f2bf(v);
                }
    }
    __syncthreads();
    f32x4 oa[2][8];
#pragma unroll
    for (int m = 0; m < 2; ++m)
#pragma unroll
        for (int n = 0; n < 8; ++n) oa[m][n] = (f32x4){0.f, 0.f, 0.f, 0.f};
    for (int ks = 0; ks < 4; ++ks) {
        bf16x8 A[2];
#pragma unroll
        for (int m = 0; m < 2; ++m) A[m] = *(LAS const bf16x8*)(Pl + (wr * 32 + m * 16 + fr) * 136 + ks * 32 + fq * 8);
#pragma unroll
        for (int n = 0; n < 8; ++n) {
            const bf16x8 B = *(const bf16x8*)(VT + (size_t)(wc * 128 + n * 16 + fr) * 2048 + ks * 32 + fq * 8);
#pragma unroll
            for (int m = 0; m < 2; ++m) oa[m][n] = __builtin_amdgcn_mfma_f32_16x16x32_bf16(A[m], B, oa[m][n], 0, 0, 0);
        }
    }
    if (c > 0) {
        for (int ks = 0; ks < 8; ++ks) {
            bf16x8 A[2];
#pragma unroll
            for (int m = 0; m < 2; ++m) A[m] = *(LAS const bf16x8*)(Qs + (wr * 32 + m * 16 + fr) * 264 + ks * 32 + fq * 8);
#pragma unroll
            for (int n = 0; n < 8; ++n) {
                const bf16x8 B = *(const bf16x8*)(ST + (size_t)(wc * 128 + n * 16 + fr) * 256 + ks * 32 + fq * 8);
#pragma unroll
                for (int m = 0; m < 2; ++m) oa[m][n] = __builtin_amdgcn_mfma_f32_16x16x32_bf16(A[m], B, oa[m][n], 0, 0, 0);
            }
        }
    }
#pragma unroll
    for (int m = 0; m < 2; ++m)
#pragma unroll
        for (int r = 0; r < 4; ++r) {
            float s1 = 0.f, s2 = 0.f;
#pragma unroll
            for (int n = 0; n < 8; ++n) { const float v = oa[m][n][r]; s1 += v; s2 += v * v; }
#pragma unroll
            for (int o = 1; o < 16; o <<= 1) { s1 += __shfl_xor(s1, o); s2 += __shfl_xor(s2, o); }
            if (fr == 0) { const int i = wr * 32 + m * 16 + fq * 4 + r; red[(i * 2 + wc) * 2] = s1; red[(i * 2 + wc) * 2 + 1] = s2; }
        }
    __syncthreads();
    bf16* MIX = (bf16*)(p.ws + WS_MIX);
#pragma unroll
    for (int m = 0; m < 2; ++m)
#pragma unroll
        for (int r = 0; r < 4; ++r) {
            const int i = wr * 32 + m * 16 + fq * 4 + r;
            const float s1 = red[i * 4] + red[i * 4 + 2], s2 = red[i * 4 + 1] + red[i * 4 + 3];
            const float mean = s1 * (1.f / 256.f), var = fmaxf(s2 * (1.f / 256.f) - mean * mean, 0.f), rstd = 1.f / sqrtf(var + 1e-5f);
#pragma unroll
            for (int n = 0; n < 8; ++n) {
                const int v = wc * 128 + n * 16 + fr;
                const float yn = (oa[m][n][r] - mean) * rstd * p.in[I_GBG][h * 256 + v] + p.in[I_GBB][h * 256 + v];
                const float g = bf2f(ZB[(size_t)(rowb + i) * ZBW + ZB_G + h * 256 + v]);
                MIX[(size_t)(rowb + i) * DM + DA + h * 256 + v] = (bf16)f2bf(yn * siluf_(g));
            }
        }
    __syncthreads();
}

__device__ __forceinline__ void phase8(const Params& p) {
    const int gw = blockIdx.x * 8 + (threadIdx.x >> 6), NGW = gridDim.x * 8, lane = threadIdx.x & 63;
    const float* rss = (const float*)(p.ws + WS_RSS); const float* g = p.in[I_GFIN];
    for (int row = gw; row < MT; row += NGW) {
        const float rstd = 1.f / sqrtf(rss[row] * (1.f / DM) + 1e-6f);
        f32x4* o = (f32x4*)(p.out + (size_t)row * DM);
#pragma unroll
        for (int j = 0; j < 8; ++j) { const f32x4 gg = ((const f32x4*)g)[lane + 64 * j]; o[lane + 64 * j] = o[lane + 64 * j] * rstd * gg; }
    }
}

__global__ void __launch_bounds__(512, 2) mega(Params p) {
    extern __shared__ __attribute__((aligned(16))) unsigned char lds_raw[];
    LAS unsigned char* lds = (LAS unsigned char*)lds_raw;
    const int lo = p.ph_lo, hi = p.ph_hi;
#ifdef ONLY_PHASE
#define IN(k) ((k) == ONLY_PHASE && lo <= (k) && (k) < hi)
#else
#define IN(k) (lo <= (k) && (k) < hi)
#endif
#define SEAM(k) do { if (IN(k) && IN((k) + 1)) cg::this_grid().sync(); } while (0)
    unsigned char* ws = p.ws;
    if (IN(0)) { phase0(p, lds); } SEAM(0);
    if (IN(1)) {
        pg8::Gemm g{(const bf16*)(ws + WS_XN), (const bf16*)(ws + WS_WINT), MPAD, NCPAD, DM}; pg8::StaticOrder S; S.init(MPAD, NCPAD, gridDim.x, blockIdx.x);
        Epi1 E{(float*)(ws + WS_ZA), (bf16*)(ws + WS_ZB), (const float2*)(ws + WS_ROT)};
        pg8::gemm_phase<Epi1, pg8::StaticOrder, true, true>(lds, g, S, E);
    } SEAM(1);
    if (IN(2)) { phase2(p, lds); } SEAM(2);
    if (IN(3)) { phase3(p, lds); } SEAM(3);
    if (IN(4)) { phase4(p); } SEAM(4);
    if (IN(5)) {
        for (int u = blockIdx.x; u < 256; u += gridDim.x) stepC_unit(p, u, lds);
        { pg8::Gemm g{(const bf16*)(ws + WS_PB), (const bf16*)(ws + WS_WPLET), MPAD, DM, 256}; pg8::StaticOrder S; S.init(MPAD, DM, gridDim.x, blockIdx.x);
          EpiPle E{(bf16*)(ws + WS_PLE)};
          pg8::gemm_phase<EpiPle, pg8::StaticOrder, true, true>(lds, g, S, E); }
    } SEAM(5);
    if (IN(6)) {
        { pg8::Gemm g{(const bf16*)(ws + WS_MIX), (const bf16*)(ws + WS_WOUTT), MPAD, DM, DM}; pg8::StaticOrder S; S.init(MPAD, DM, gridDim.x, blockIdx.x);
          Epi2 E{p.in[I_XP], p.in[I_XS], (float*)(ws + WS_H2), (bf16*)(ws + WS_H2B)};
          pg8::gemm_phase<Epi2, pg8::StaticOrder, true, true>(lds, g, S, E); }
    } SEAM(6);
    if (IN(7)) {
        pg8::Gemm g{(const bf16*)(ws + WS_H2B), (const bf16*)(ws + WS_WGT), MPAD, DM, DM}; pg8::StaticOrder S; S.init(MPAD, DM, gridDim.x, blockIdx.x);
        Epi3 E{(const float*)(ws + WS_H2), (const bf16*)(ws + WS_PLE), p.out, (float*)(ws + WS_RSS)};
        pg8::gemm_phase<Epi3, pg8::StaticOrder, true, true>(lds, g, S, E);
    } SEAM(7);
    if (IN(8)) { phase8(p); }
#undef IN
#undef SEAM
}

#ifndef N_LAUNCH_PER_PHASE
#define N_LAUNCH_PER_PHASE 1
#endif
extern "C" void kernel_launch(void* const* d_in, const int* in_sizes, int n_in, void* d_out, int out_size, void* d_ws, size_t ws_size, hipStream_t stream) {
    static int grid = 0;
    if (grid == 0) {
        if (n_in != 25 || ws_size < WS_END) { fprintf(stderr, "kernel_launch: unexpected inputs (n_in %d, ws %zu < %zu)\n", n_in, ws_size, (size_t)WS_END); grid = -1; return; }
        int dev = 0, cus = 0, per_cu = 0;
        hipGetDevice(&dev); hipDeviceGetAttribute(&cus, hipDeviceAttributeMultiprocessorCount, dev);
        if (hipFuncSetAttribute((const void*)mega, hipFuncAttributeMaxDynamicSharedMemorySize, LDS_BYTES) != hipSuccess) { fprintf(stderr, "hipFuncSetAttribute failed\n"); grid = -1; return; }
        hipOccupancyMaxActiveBlocksPerMultiprocessor(&per_cu, (const void*)mega, 512, LDS_BYTES);
        if (per_cu < 1) per_cu = 1;
        grid = cus * per_cu;
        (void)hipGetLastError();
    }
    if (grid < 0) return;
    Params p{};
    for (int i = 0; i < 25; ++i) p.in[i] = (const float*)d_in[i];
    p.out = (float*)d_out; p.ws = (unsigned char*)d_ws;
#if N_LAUNCH_PER_PHASE
    for (int ph = 0; ph < 9; ++ph) { p.ph_lo = ph; p.ph_hi = ph + 1; hipLaunchKernelGGL(mega, dim3(grid), dim3(512), LDS_BYTES, stream, p); }
#else
    p.ph_lo = 0; p.ph_hi = 9;
    void* args[] = {&p};
    hipError_t e = hipLaunchCooperativeKernel((const void*)mega, dim3(grid), dim3(512), args, LDS_BYTES, stream);
    if (e != hipSuccess) fprintf(stderr, "cooperative launch failed: %s (grid %d)\n", hipGetErrorString(e), grid);
#endif
}
```

```cpp
#include <hip/hip_runtime.h>
#include <hip/hip_cooperative_groups.h>
#include <cstdio>
#include <cstdint>
namespace cg = cooperative_groups;
namespace pg8 {
#define PG8_LAS __attribute__((address_space(3)))
typedef unsigned short bf16_t;
typedef short bf16x8 __attribute__((ext_vector_type(8)));
typedef float f32x4 __attribute__((ext_vector_type(4)));
typedef unsigned u32x4 __attribute__((ext_vector_type(4)));
constexpr int BM = 256, BK = 64, HALF = 128, HTB = HALF * BK * 2  , STAGE_BYTES = 8 * HTB, NXCD = 8, WGM = 8;

__host__ __device__ __forceinline__ int lds_byte(int r, int c) { const int st = (r >> 4) * 2 + (c >> 5), rr = r & 15, cc = c & 31, ob = rr * 64 + cc * 2; return st * 1024 + (ob ^ (((ob >> 9) & 1) << 5)); }
__host__ __device__ __forceinline__ void stage_rc(int b, int& R, int& C) { const int st = b / 1024, sb = b % 1024, swz = sb ^ (((sb >> 9) & 1) << 5); R = (st >> 1) * 16 + swz / 64; C = (st & 1) * 32 + (swz % 64) / 2; }
__host__ __device__ __forceinline__ int perm32(int rho) { const int n = rho >> 4, i = rho & 15; return 8 * (i >> 2) + 4 * n + (i & 3); }

struct Unit { int pm, pn; };
struct Gemm { const bf16_t* A; const bf16_t* Bt; int M, N, K; };

struct StaticOrder {
    int nM, nN, nwg, G, c;
    __host__ __device__ void init(int M, int N, int G_, int c_) { nM = M / BM; nN = N / BM; nwg = nM * nN; G = G_; c = c_; }
    __host__ __device__ bool next(int i, Unit& u) const {
        const long L = (long)i * G + c; if (L >= nwg) return false;
        int wgid = (int)L; { const int q = nwg / NXCD, r = nwg % NXCD, xcd = wgid % NXCD, off = wgid / NXCD; wgid = (xcd < r ? xcd * (q + 1) : r * (q + 1) + (xcd - r) * q) + off; }
        const int nig = WGM * nN, gid = wgid / nig, fm = gid * WGM, gsz = (nM - fm) < WGM ? (nM - fm) : WGM;
        u.pm = fm + ((wgid % nig) % gsz); u.pn = (wgid % nig) / gsz; return true;
    }
    __device__ __forceinline__ void a_ready(const Unit&) const {}
    __device__ __forceinline__ void done(const Unit&) const {}
};
__device__ __forceinline__ unsigned cvt_pk_bf16(float lo, float hi) { unsigned r; asm volatile("v_cvt_pk_bf16_f32 %0, %1, %2" : "=v"(r) : "v"(lo), "v"(hi)); return r; }
typedef float f32x2 __attribute__((ext_vector_type(2)));
template <class Epi, class Sched, bool ALIGN_EPI = false, bool SP2 = false>
__device__ __forceinline__ void gemm_phase(PG8_LAS unsigned char* lds, const Gemm g, const Sched& S, const Epi& E, const int tid_) {
    const int tid = tid_, wid = __builtin_amdgcn_readfirstlane(tid >> 6), lane = tid & 63, wr = wid >> 2, wc = wid & 3, fr = lane & 15, fq = lane >> 4;
    const int K = g.K, nt = K / BK;
    unsigned voffA[2], voffB[2];
#pragma unroll
    for (int i = 0; i < 2; ++i) { int R, C; stage_rc(tid * 16 + i * 8192, R, C); const int Rb = Epi::PERM ? ((R & ~31) + perm32(R & 31)) : R;
        voffA[i] = (unsigned)(R * K + C) * 2u; voffB[i] = (unsigned)(Rb * K + C) * 2u; }
    const size_t kstep = (size_t)(BK * 2);
    const size_t hstep = (size_t)HALF * K * 2;
    const size_t tstep = 2 * hstep;
    const unsigned ldsw = (unsigned)wid * 1024u;
    const int aoff = lds_byte(wr * 64 + fr, fq * 8), boff = lds_byte(wc * 32 + fr, fq * 8);
#define PG8_SA(b, h) (((b) * 2 + (h)) * HTB)
#define PG8_SB(b, h) ((4 + (b) * 2 + (h)) * HTB)
#define PG8_STAGE(bufoff, gbase, voff) do { _Pragma("unroll") for (int _i = 0; _i < 2; ++_i) \
        __builtin_amdgcn_global_load_lds((const unsigned*)((const char*)(gbase) + (voff)[_i]), (PG8_LAS unsigned*)(lds + (bufoff) + ldsw + _i * 8192), 16, 0, 0); } while (0)
#define PG8_LDA(dst, b, h) do { _Pragma("unroll") for (int m = 0; m < 4; ++m) _Pragma("unroll") for (int k = 0; k < 2; ++k) dst[m][k] = *(const PG8_LAS bf16x8*)(lds + PG8_SA(b, h) + aoff + m * 2048 + k * 1024); } while (0)
#define PG8_LDB(dst, b, h) do { _Pragma("unroll") for (int n = 0; n < 2; ++n) _Pragma("unroll") for (int k = 0; k < 2; ++k) dst[n][k] = *(const PG8_LAS bf16x8*)(lds + PG8_SB(b, h) + boff + n * 2048 + k * 1024); } while (0)
#define PG8_MMA(ai, bj, At, Bt) do { __builtin_amdgcn_s_setprio(1); _Pragma("unroll") for (int m = 0; m < 4; ++m) _Pragma("unroll") for (int n = 0; n < 2; ++n) _Pragma("unroll") for (int k = 0; k < 2; ++k) \
        acc[ai][bj][m][n] = __builtin_amdgcn_mfma_f32_16x16x32_bf16(Bt[n][k], At[m][k], acc[ai][bj][m][n], 0, 0, 0); __builtin_amdgcn_s_setprio(0); } while (0)
#define PG8_WAIT_V(n) asm volatile("s_waitcnt vmcnt(" #n ")" ::: "memory")
#define PG8_WAIT_L(n) asm volatile("s_waitcnt lgkmcnt(" #n ")" ::: "memory")
#define PG8_BAR __builtin_amdgcn_s_barrier()
#define PG8_SCHED __builtin_amdgcn_sched_barrier(0)
    Unit cur, nxt; int ui = 0;
    if (!S.next(0, cur)) return;
    f32x4 acc[2][2][4][2];
#pragma unroll
    for (int a = 0; a < 2; ++a)
#pragma unroll
        for (int b = 0; b < 2; ++b)
#pragma unroll
            for (int m = 0; m < 4; ++m)
#pragma unroll
                for (int n = 0; n < 2; ++n) acc[a][b][m][n] = (f32x4){0.f, 0.f, 0.f, 0.f};
    bf16x8 At[4][2], B0[2][2], B1[2][2];
    const char* cA = (const char*)g.A + (size_t)cur.pm * tstep; const char* cB = (const char*)g.Bt + (size_t)cur.pn * tstep;
    S.a_ready(cur);
    if constexpr (SP2) {
        PG8_STAGE(PG8_SB(0, 0), cB, voffB); PG8_STAGE(PG8_SB(0, 1), cB + hstep, voffB); PG8_STAGE(PG8_SA(0, 0), cA, voffA); PG8_STAGE(PG8_SA(0, 1), cA + hstep, voffA);
        if (wr == 1) PG8_BAR;
        PG8_WAIT_V(2); PG8_BAR;
        PG8_STAGE(PG8_SB(1, 0), cB + kstep, voffB); PG8_STAGE(PG8_SA(1, 0), cA + kstep, voffA); PG8_STAGE(PG8_SB(1, 1), cB + hstep + kstep, voffB);
        PG8_WAIT_V(6); PG8_BAR;
    } else {
        PG8_STAGE(PG8_SB(0, 0), cB, voffB); PG8_STAGE(PG8_SA(0, 0), cA, voffA); PG8_STAGE(PG8_SB(0, 1), cB + hstep, voffB); PG8_STAGE(PG8_SA(0, 1), cA + hstep, voffA);
        if (wr == 1) PG8_BAR;
        PG8_WAIT_V(4); PG8_BAR;
        PG8_STAGE(PG8_SB(1, 0), cB + kstep, voffB); PG8_STAGE(PG8_SA(1, 0), cA + kstep, voffA); PG8_STAGE(PG8_SB(1, 1), cB + hstep + kstep, voffB);
        PG8_WAIT_V(6); PG8_BAR;
    }
    for (;;) {
        const bool has_next = S.next(ui + 1, nxt);
        const char* nA = has_next ? (const char*)g.A + (size_t)nxt.pm * tstep : cA; const char* nB = has_next ? (const char*)g.Bt + (size_t)nxt.pn * tstep : cB;
        for (int t = 0; t < nt; t += 2) {
            const bool last = (t == nt - 2);
            const char* a1 = cA + (size_t)(t + 1) * kstep;
            const char* a2 = last ? nA : cA + (size_t)(t + 2) * kstep; const char* b2 = last ? nB : cB + (size_t)(t + 2) * kstep;
            const char* a3 = a2 + kstep; const char* b3 = b2 + kstep;
            if (last && has_next) S.a_ready(nxt);
            if constexpr (SP2) {
            PG8_LDB(B0, 0, 0); PG8_LDB(B1, 0, 1); PG8_SCHED; PG8_LDA(At, 0, 0); PG8_STAGE(PG8_SA(1, 1), a1 + hstep, voffA);
            PG8_WAIT_V(8); PG8_WAIT_L(0); PG8_BAR; PG8_MMA(0, 0, At, B0); PG8_MMA(0, 1, At, B1); PG8_BAR; PG8_SCHED;
            PG8_LDA(At, 0, 1); PG8_STAGE(PG8_SB(0, 0), b2, voffB); PG8_STAGE(PG8_SB(0, 1), b2 + hstep, voffB); PG8_STAGE(PG8_SA(0, 0), a2, voffA);
            PG8_WAIT_V(8); PG8_WAIT_L(0); PG8_BAR; PG8_MMA(1, 0, At, B0); PG8_MMA(1, 1, At, B1); PG8_BAR; PG8_SCHED;
            PG8_LDB(B0, 1, 0); PG8_LDB(B1, 1, 1); PG8_SCHED; PG8_LDA(At, 1, 0); PG8_STAGE(PG8_SA(0, 1), a2 + hstep, voffA);
            PG8_WAIT_V(8); PG8_WAIT_L(0); PG8_BAR; PG8_MMA(0, 0, At, B0); PG8_MMA(0, 1, At, B1); PG8_BAR; PG8_SCHED;
            PG8_LDA(At, 1, 1); PG8_STAGE(PG8_SB(1, 0), b3, voffB); PG8_STAGE(PG8_SB(1, 1), b3 + hstep, voffB); PG8_STAGE(PG8_SA(1, 0), a3, voffA);
            PG8_WAIT_V(8); PG8_WAIT_L(0); PG8_BAR; PG8_MMA(1, 0, At, B0); PG8_MMA(1, 1, At, B1); PG8_BAR; PG8_SCHED;
            } else {
            PG8_LDB(B0, 0, 0); PG8_SCHED; PG8_LDA(At, 0, 0); PG8_STAGE(PG8_SA(1, 1), a1 + hstep, voffA);
            PG8_WAIT_L(8); PG8_BAR; PG8_WAIT_L(0); PG8_MMA(0, 0, At, B0); PG8_BAR; PG8_SCHED;
            PG8_LDB(B1, 0, 1); PG8_STAGE(PG8_SB(0, 0), b2, voffB);
            PG8_BAR; PG8_WAIT_L(0); PG8_MMA(0, 1, At, B1); PG8_BAR;
            PG8_LDA(At, 0, 1); PG8_STAGE(PG8_SA(0, 0), a2, voffA);
            PG8_BAR; PG8_WAIT_L(0); PG8_MMA(1, 0, At, B0); PG8_BAR; PG8_SCHED;
            PG8_STAGE(PG8_SB(0, 1), b2 + hstep, voffB);
            PG8_WAIT_V(6); PG8_BAR; PG8_MMA(1, 1, At, B1); PG8_BAR;
            PG8_LDB(B0, 1, 0); PG8_SCHED; PG8_LDA(At, 1, 0); PG8_STAGE(PG8_SA(0, 1), a2 + hstep, voffA);
            PG8_WAIT_L(8); PG8_BAR; PG8_WAIT_L(0); PG8_MMA(0, 0, At, B0); PG8_BAR; PG8_SCHED;
            PG8_LDB(B1, 1, 1); PG8_STAGE(PG8_SB(1, 0), b3, voffB);
            PG8_BAR; PG8_WAIT_L(0); PG8_MMA(0, 1, At, B1); PG8_BAR;
            PG8_LDA(At, 1, 1); PG8_STAGE(PG8_SA(1, 0), a3, voffA);
            PG8_BAR; PG8_WAIT_L(0); PG8_MMA(1, 0, At, B0); PG8_BAR; PG8_SCHED;
            PG8_STAGE(PG8_SB(1, 1), b3 + hstep, voffB);
            PG8_WAIT_V(6); PG8_BAR; PG8_MMA(1, 1, At, B1); PG8_BAR;
            }
        }
        if constexpr (ALIGN_EPI) { if (wr == 0) PG8_BAR; }
        if constexpr (!Epi::AFTER_DRAIN) { E(acc, cur, wr, wc, fr, fq); S.done(cur); }
        if (!has_next) break;
#pragma unroll
        for (int a = 0; a < 2; ++a)
#pragma unroll
            for (int b = 0; b < 2; ++b)
#pragma unroll
                for (int m = 0; m < 4; ++m)
#pragma unroll
                    for (int n = 0; n < 2; ++n) acc[a][b][m][n] = (f32x4){0.f, 0.f, 0.f, 0.f};
        cur = nxt; cA = nA; cB = nB; ++ui;
        if constexpr (ALIGN_EPI) { if (wr == 1) PG8_BAR; }
    }
    PG8_WAIT_V(0);
    if constexpr (!ALIGN_EPI) { if (wr == 0) PG8_BAR; }
    PG8_BAR;
    if constexpr (Epi::AFTER_DRAIN) { E.fused(acc, cur, wr, wc, fr, fq, lds, wid, lane); S.done(cur); }
#undef PG8_SA
#undef PG8_SB
#undef PG8_STAGE
#undef PG8_LDA
#undef PG8_LDB
#undef PG8_MMA
#undef PG8_WAIT_V
#undef PG8_WAIT_L
#undef PG8_BAR
#undef PG8_SCHED
}
}

#define LAS __attribute__((address_space(3)))
typedef unsigned short bf16;
typedef float f32x4 __attribute__((ext_vector_type(4)));
typedef short bf16x8 __attribute__((ext_vector_type(8)));
typedef unsigned u32x4 __attribute__((ext_vector_type(4)));

constexpr int DM = 2048, SEQ = 2048, NBP = 4, MP = 8192, MS = 128, MT = 8320, MPAD = 8448;
constexpr int DA = 1024, HA = 16, ASH = 3200, NCPAD = 8448, ZBW = 5248;
constexpr int HB = 4, HDB = 256;
constexpr int ZB_GA = 0, ZB_Q = 1024, ZB_K = 2048, ZB_V = 3072, ZB_G = 4096;
constexpr size_t MiB = 1u << 20;
constexpr size_t WS_CTL = 0, WS_WINT = 1 * MiB, WS_XN = 34 * MiB, WS_GT = 1 * MiB, WS_WOUTT = 67 * MiB, WS_WGT = 75 * MiB, WS_WPLET = 83 * MiB,
                 WS_PB = 84 * MiB, WS_ROT = 89 * MiB, WS_ZA = 92 * MiB, WS_YA = 92 * MiB, WS_MIX = 125 * MiB, WS_ST = 158 * MiB, WS_ZB = 196 * MiB, WS_PLE = 1 * MiB,
                 WS_OPS = 281 * MiB, WS_OPSS = 473 * MiB, WS_H2 = 281 * MiB, WS_H2B = 347 * MiB, WS_KDT = 476 * MiB, WS_VT = 492 * MiB, WS_RSS = 508 * MiB, WS_END = 509 * MiB, WS_OPSA = 281 * MiB, WS_CH = 377 * MiB, WS_WWBT = 91 * MiB + 512 * 1024, WS_WABT = WS_WWBT + 128 * 1024;
constexpr size_t O_Y = 0, O_WKVP = 17039360, O_SHP = 17301504, O_RETP = 17314304, O_WKVS = 18362880, O_SHS = 26751488, O_RETS = 27161088;
constexpr int LDS_BYTES = 135168;

struct Params { const float* in[25]; float* out; unsigned char* ws; int ph_lo, ph_hi; };
typedef __attribute__((address_space(4))) const Params* KParams;
__device__ __forceinline__ int my_tid(int wv) { unsigned m = ~0u; asm volatile("" : "+s"(m), "+s"(wv)); return wv * 64 + (int)__builtin_amdgcn_mbcnt_hi(m, __builtin_amdgcn_mbcnt_lo(m, 0u)); }
__device__ __forceinline__ const Params& kparams() { auto k = __builtin_amdgcn_kernarg_segment_ptr(); asm volatile("" : "+s"(k)); return *(const Params*)(KParams)k; }
enum { I_XP = 0, I_XS, I_PP, I_PS, I_SWKV, I_SSHIFT, I_SRET, I_GLN, I_WIN, I_MU, I_W0, I_WWB, I_A0, I_WAB, I_KK, I_KA, I_RK, I_GAG, I_GAB, I_GBG, I_GBB, I_WOUT, I_WPLE, I_WGATE, I_GFIN };

typedef float f32x2_t __attribute__((ext_vector_type(2)));
typedef __bf16 bf16x2_t __attribute__((ext_vector_type(2)));
__device__ __forceinline__ unsigned pk2(float lo, float hi) { const f32x2_t v = {lo, hi}; const bf16x2_t r = __builtin_convertvector(v, bf16x2_t); return __builtin_bit_cast(unsigned, r); }
__device__ __forceinline__ unsigned f2bf(float f) { return pk2(f, f) & 0xffffu; }
__device__ __forceinline__ float bf2f(unsigned h) { return __builtin_bit_cast(float, h << 16); }
__device__ __forceinline__ float bflo(unsigned w) { return __builtin_bit_cast(float, w << 16); }
__device__ __forceinline__ float bfhi(unsigned w) { return __builtin_bit_cast(float, w & 0xffff0000u); }
__device__ __forceinline__ float wave_sum(float v) {
#pragma unroll
    for (int o = 1; o < 64; o <<= 1) v += __shfl_xor(v, o);
    return v;
}
__device__ __forceinline__ float sigmoidf_(float x) { return 1.f / (1.f + __expf(-x)); }
__device__ __forceinline__ float siluf_(float x) { return x / (1.f + __expf(-x)); }
__device__ __forceinline__ float gamma_h(int h) { return 1.f - exp2f(-5.f - (float)h); }
__device__ __forceinline__ float gpow(int h, float n) { return (float)exp((double)n * log(1.0 - exp2(-5.0 - (double)h))); }

template <int N> __device__ __forceinline__ float ror_add(float x) {
    const int y = __builtin_amdgcn_update_dpp(0, __builtin_bit_cast(int, x), 0x120 + N, 0xf, 0xf, false);
    return x + __builtin_bit_cast(float, y);
}
__device__ __forceinline__ float row16_sum(float x) { x = ror_add<8>(x); x = ror_add<4>(x); x = ror_add<2>(x); x = ror_add<1>(x); return x; }

__device__ __forceinline__ void p0_transpose_item(const float* W, int K, int N, bf16* WT, LAS float* scr, int item, int lane) {
    const int nblk = N / 32, kb = item / nblk, nb = item % nblk, k0 = 64 * kb, n0 = 32 * nb;
#pragma unroll 8
    for (int i = 0; i < 32; ++i) { const int kk = 2 * i + (lane >> 5); scr[kk * 33 + (lane & 31)] = W[(size_t)(k0 + kk) * N + n0 + (lane & 31)]; }
    asm volatile("s_waitcnt lgkmcnt(0)" ::: "memory");
    const int c = lane & 7;
#pragma unroll
    for (int j = 0; j < 4; ++j) { const int n = (lane >> 3) + 8 * j; const LAS float* s = scr + (8 * c) * 33 + n;
        u32x4 o; o.x = pk2(s[0 * 33], s[1 * 33]); o.y = pk2(s[2 * 33], s[3 * 33]); o.z = pk2(s[4 * 33], s[5 * 33]); o.w = pk2(s[6 * 33], s[7 * 33]);
        *(u32x4*)(WT + (size_t)(n0 + n) * K + k0 + 8 * c) = o; }
    asm volatile("s_waitcnt lgkmcnt(0)" ::: "memory");
}

__device__ __forceinline__ void phase0(const Params& p, LAS unsigned char* lds, const int tid_) {
    const int tid = tid_, lane = tid & 63, wave = tid >> 6;
    const int gw = blockIdx.x * 8 + wave, NGW = gridDim.x * 8;
    unsigned char* ws = p.ws;
    LAS float* scr = (LAS float*)(lds + wave * 16384);
    constexpr int I_IN = 32 * 260, I_O = 32 * 64, I_G = 32 * 64, I_P = 4 * 64, I_L = 32, NIT = I_IN + I_O + I_G + I_P + 2 * I_L;
    for (int it = gw; it < NIT; it += NGW) {
        int r = it;
        if (r < I_IN) { p0_transpose_item(p.in[I_WIN], 2048, 8320, (bf16*)(ws + WS_WINT), scr, r, lane); continue; } r -= I_IN;
        if (r < I_O) { p0_transpose_item(p.in[I_WOUT], 2048, 2048, (bf16*)(ws + WS_WOUTT), scr, r, lane); continue; } r -= I_O;
        if (r < I_G) { p0_transpose_item(p.in[I_WGATE], 2048, 2048, (bf16*)(ws + WS_WGT), scr, r, lane); continue; } r -= I_G;
        if (r < I_P) { p0_transpose_item(p.in[I_WPLE], 256, 2048, (bf16*)(ws + WS_WPLET), scr, r, lane); continue; } r -= I_P;
        if (r < I_L) { p0_transpose_item(p.in[I_WWB], 64, 1024, (bf16*)(ws + WS_WWBT), scr, r, lane); continue; } r -= I_L;
        p0_transpose_item(p.in[I_WAB], 64, 1024, (bf16*)(ws + WS_WABT), scr, r, lane);
    }
    const float* g = p.in[I_GLN];
    for (int row = gw; row < MT; row += NGW) {
        const float* xr = row < MP ? p.in[I_XP] + (size_t)row * DM : p.in[I_XS] + (size_t)(row - MP) * DM;
        f32x4 v[8]; float s = 0.f;
#pragma unroll
        for (int j = 0; j < 8; ++j) { v[j] = ((const f32x4*)xr)[lane + 64 * j]; s += (v[j].x * v[j].x + v[j].y * v[j].y) + (v[j].z * v[j].z + v[j].w * v[j].w); }
        const float rstd = 1.f / sqrtf(wave_sum(s) * (1.f / DM) + 1e-6f);
        unsigned long long* o8 = (unsigned long long*)((bf16*)(ws + WS_XN) + (size_t)row * DM);
#pragma unroll
        for (int j = 0; j < 8; ++j) { const f32x4 gg = ((const f32x4*)g)[lane + 64 * j];
            o8[lane + 64 * j] = (unsigned long long)pk2(v[j].x * rstd * gg.x, v[j].y * rstd * gg.y) | ((unsigned long long)pk2(v[j].z * rstd * gg.z, v[j].w * rstd * gg.w) << 32); }
    }
    for (int row = gw; row < MT; row += NGW) {
        const float* pr = row < MP ? p.in[I_PP] + (size_t)row * 256 : p.in[I_PS] + (size_t)(row - MP) * 256;
        const f32x4 v = ((const f32x4*)pr)[lane];
        ((unsigned long long*)((bf16*)(ws + WS_PB) + (size_t)row * 256))[lane] = (unsigned long long)pk2(v.x, v.y) | ((unsigned long long)pk2(v.z, v.w) << 32);
    }
    {
        float2* tab = (float2*)(ws + WS_ROT);
        const int gt = blockIdx.x * 512 + tid, NT = gridDim.x * 512;
        for (int e = gt; e < 2049 * 128; e += NT) {
            const int pi = e >> 7, i = e & 127;
            const float pos = pi < 2048 ? (float)pi : 16384.f;
            const float lin = (float)i / 127.f;
            const float angle = 1.0f / powf(10000.f, lin);
            const float theta = pos * angle;
            tab[e] = make_float2((float)cos((double)theta), (float)sin((double)theta));
        }
        float* rss = (float*)(ws + WS_RSS);
        for (int e = gt; e < MPAD; e += NT) rss[e] = 0.f;
    }
}

struct Epi1 {
    static constexpr bool PERM = true, AFTER_DRAIN = false;
    bf16* ZA; bf16* ZB; const float2* rot;
    __device__ __forceinline__ void operator()(const pg8::f32x4 (&acc)[2][2][4][2], const pg8::Unit& u, int wr, int wc, int fr, int fq) const {
#pragma unroll
        for (int ai = 0; ai < 2; ++ai)
#pragma unroll
            for (int m = 0; m < 4; ++m) {
                const int row = u.pm * 256 + ai * 128 + wr * 64 + m * 16 + fr;
                if (row >= MT) continue;
                const int pidx = row < MP ? (row & 2047) : 2048;
#pragma unroll
                for (int bj = 0; bj < 2; ++bj) {
                    const int c0 = u.pn * 256 + bj * 128 + wc * 32 + 8 * fq;
                    if (c0 >= 8320) continue;
                    pg8::f32x4 v0 = acc[ai][bj][m][0], v1 = acc[ai][bj][m][1];
                    if (c0 < ASH) { u32x4 w; w.x = pg8::cvt_pk_bf16(v0.x, v0.y); w.y = pg8::cvt_pk_bf16(v0.z, v0.w); w.z = pg8::cvt_pk_bf16(v1.x, v1.y); w.w = pg8::cvt_pk_bf16(v1.z, v1.w); *(u32x4*)(ZA + (size_t)row * ASH + c0) = w; }
                    else {
                        if (c0 >= 4224 && c0 < 6272) {
                            const int dl = (c0 - 4224) & 255;
                            const float2* t = rot + (size_t)pidx * 128 + (dl >> 1);
                            const float sc = c0 >= 5248 ? 0.0625f : 1.f;
                            const float2 t0 = t[0], t1 = t[1], t2 = t[2], t3 = t[3];
                            pg8::f32x4 r0, r1;
                            r0.x = (v0.x * t0.x - v0.y * t0.y) * sc; r0.y = (v0.x * t0.y + v0.y * t0.x) * sc;
                            r0.z = (v0.z * t1.x - v0.w * t1.y) * sc; r0.w = (v0.z * t1.y + v0.w * t1.x) * sc;
                            r1.x = (v1.x * t2.x - v1.y * t2.y) * sc; r1.y = (v1.x * t2.y + v1.y * t2.x) * sc;
                            r1.z = (v1.z * t3.x - v1.w * t3.y) * sc; r1.w = (v1.z * t3.y + v1.w * t3.x) * sc;
                            v0 = r0; v1 = r1;
                        }
                        u32x4 w; w.x = pg8::cvt_pk_bf16(v0.x, v0.y); w.y = pg8::cvt_pk_bf16(v0.z, v0.w); w.z = pg8::cvt_pk_bf16(v1.x, v1.y); w.w = pg8::cvt_pk_bf16(v1.z, v1.w);
                        *(u32x4*)(ZB + (size_t)row * ZBW + (c0 - ASH)) = w;
                    }
                }
            }
    }
};
struct EpiPle {
    static constexpr bool PERM = true, AFTER_DRAIN = false;
    bf16* O;
    __device__ __forceinline__ void operator()(const pg8::f32x4 (&acc)[2][2][4][2], const pg8::Unit& u, int wr, int wc, int fr, int fq) const {
#pragma unroll
        for (int ai = 0; ai < 2; ++ai)
#pragma unroll
            for (int m = 0; m < 4; ++m) {
                const int row = u.pm * 256 + ai * 128 + wr * 64 + m * 16 + fr;
#pragma unroll
                for (int bj = 0; bj < 2; ++bj) {
                    const int c0 = u.pn * 256 + bj * 128 + wc * 32 + 8 * fq;
                    const pg8::f32x4 v0 = acc[ai][bj][m][0], v1 = acc[ai][bj][m][1];
                    u32x4 w; w.x = pg8::cvt_pk_bf16(v0.x, v0.y); w.y = pg8::cvt_pk_bf16(v0.z, v0.w); w.z = pg8::cvt_pk_bf16(v1.x, v1.y); w.w = pg8::cvt_pk_bf16(v1.z, v1.w);
                    *(u32x4*)(O + (size_t)row * DM + c0) = w;
                }
            }
    }
};
struct Epi2 {
    static constexpr bool PERM = true, AFTER_DRAIN = false;
    const float* xp; const float* xs; float* H2; bf16* H2B;
    __device__ __forceinline__ void operator()(const pg8::f32x4 (&acc)[2][2][4][2], const pg8::Unit& u, int wr, int wc, int fr, int fq) const {
#pragma unroll
        for (int ai = 0; ai < 2; ++ai)
#pragma unroll
            for (int m = 0; m < 4; ++m) {
                const int row = u.pm * 256 + ai * 128 + wr * 64 + m * 16 + fr;
                if (row >= MT) continue;
                const float* xr = row < MP ? xp + (size_t)row * DM : xs + (size_t)(row - MP) * DM;
#pragma unroll
                for (int bj = 0; bj < 2; ++bj) {
                    const int c0 = u.pn * 256 + bj * 128 + wc * 32 + 8 * fq;
                    const pg8::f32x4 v0 = acc[ai][bj][m][0] + *(const pg8::f32x4*)(xr + c0), v1 = acc[ai][bj][m][1] + *(const pg8::f32x4*)(xr + c0 + 4);
                    u32x4 w; w.x = pg8::cvt_pk_bf16(v0.x, v0.y); w.y = pg8::cvt_pk_bf16(v0.z, v0.w); w.z = pg8::cvt_pk_bf16(v1.x, v1.y); w.w = pg8::cvt_pk_bf16(v1.z, v1.w);
                    *(u32x4*)(H2B + (size_t)row * DM + c0) = w;
                }
            }
    }
};
struct Epi3 {
    static constexpr bool PERM = true, AFTER_DRAIN = false;
    const bf16* H2B; const bf16* PLE; bf16* H3; float* rss;
    __device__ __forceinline__ void operator()(const pg8::f32x4 (&acc)[2][2][4][2], const pg8::Unit& u, int wr, int wc, int fr, int fq) const {
#pragma unroll
        for (int ai = 0; ai < 2; ++ai)
#pragma unroll
            for (int m = 0; m < 4; ++m) {
                const int row = u.pm * 256 + ai * 128 + wr * 64 + m * 16 + fr;
                const bool ok = row < MT;
                float ss = 0.f;
#pragma unroll
                for (int bj = 0; bj < 2; ++bj) {
                    const int c0 = u.pn * 256 + bj * 128 + wc * 32 + 8 * fq;
                    if (ok) {
                        const pg8::f32x4 a0 = acc[ai][bj][m][0], a1 = acc[ai][bj][m][1];
                        const u32x4 hw = *(const u32x4*)(H2B + (size_t)row * DM + c0);
                        const pg8::f32x4 h0 = (pg8::f32x4){bflo(hw.x), bfhi(hw.x), bflo(hw.y), bfhi(hw.y)}, h1 = (pg8::f32x4){bflo(hw.z), bfhi(hw.z), bflo(hw.w), bfhi(hw.w)};
                        const u32x4 pw = *(const u32x4*)(PLE + (size_t)row * DM + c0);
                        pg8::f32x4 o0, o1;
                        o0.x = h0.x + sigmoidf_(a0.x) * bflo(pw.x); o0.y = h0.y + sigmoidf_(a0.y) * bfhi(pw.x);
                        o0.z = h0.z + sigmoidf_(a0.z) * bflo(pw.y); o0.w = h0.w + sigmoidf_(a0.w) * bfhi(pw.y);
                        o1.x = h1.x + sigmoidf_(a1.x) * bflo(pw.z); o1.y = h1.y + sigmoidf_(a1.y) * bfhi(pw.z);
                        o1.z = h1.z + sigmoidf_(a1.z) * bflo(pw.w); o1.w = h1.w + sigmoidf_(a1.w) * bfhi(pw.w);
                        { u32x4 w; w.x = pg8::cvt_pk_bf16(o0.x, o0.y); w.y = pg8::cvt_pk_bf16(o0.z, o0.w); w.z = pg8::cvt_pk_bf16(o1.x, o1.y); w.w = pg8::cvt_pk_bf16(o1.z, o1.w); *(u32x4*)(H3 + (size_t)row * DM + c0) = w; }
                        ss += (o0.x * o0.x + o0.y * o0.y) + (o0.z * o0.z + o0.w * o0.w) + (o1.x * o1.x + o1.y * o1.y) + (o1.z * o1.z + o1.w * o1.w);
                    }
                }
                ss += __shfl_xor(ss, 16); ss += __shfl_xor(ss, 32);
                if (ok && fq == 0) atomicAdd(rss + row, ss);
            }
    }
};

__device__ __forceinline__ f32x4 ldz4(const bf16* q) { const unsigned long long w = *(const unsigned long long*)q; return (f32x4){bflo((unsigned)w), bfhi((unsigned)w), bflo((unsigned)(w >> 32)), bfhi((unsigned)(w >> 32))}; }
__device__ __forceinline__ f32x4 za_xs4(const Params& p, const bf16* ZA, int row, int col) {
    const f32x4 f = ldz4(ZA + (size_t)row * ASH + col), mu = *(const f32x4*)(p.in[I_MU] + col);
    f32x4 pv;
    if (row < MP) { if (row & 2047) pv = ldz4(ZA + (size_t)(row - 1) * ASH + col); else pv = (f32x4){0.f, 0.f, 0.f, 0.f}; }
    else pv = *(const f32x4*)(p.in[I_SSHIFT] + (size_t)(row - MP) * ASH + col);
    return f + mu * (pv - f);
}
__device__ __forceinline__ void prep_item(const Params& p, int item, LAS unsigned char* lds, const int tid_) {
    const int tid = tid_, wave = tid >> 6, lane = tid & 63, fr = lane & 15, fq = lane >> 4;
    const int row0 = item * 16;
    const bf16* ZA = (const bf16*)(p.ws + WS_ZA);
    LAS float* lw = (LAS float*)lds;
    LAS float* la = lw + 16 * 512;
    LAS bf16* xwb = (LAS bf16*)(lds + 65536);
    LAS bf16* xab = xwb + 16 * 72;
    {
        const int tok = tid >> 5, j4 = (tid & 31) * 4;
        const f32x4 xs = za_xs4(p, ZA, row0 + tok, 3072 + j4);
        if (j4 < 64) *(LAS unsigned long long*)(xwb + tok * 72 + j4) = (unsigned long long)pk2(tanhf(xs.x), tanhf(xs.y)) | ((unsigned long long)pk2(tanhf(xs.z), tanhf(xs.w)) << 32);
        else *(LAS unsigned long long*)(xab + tok * 72 + j4 - 64) = (unsigned long long)pk2(xs.x, xs.y) | ((unsigned long long)pk2(xs.z, xs.w) << 32);
    }
    __syncthreads();
    bf16x8 aw[2], aa[2];
#pragma unroll
    for (int ks = 0; ks < 2; ++ks) { aw[ks] = *(LAS const bf16x8*)(xwb + fr * 72 + ks * 32 + fq * 8); aa[ks] = *(LAS const bf16x8*)(xab + fr * 72 + ks * 32 + fq * 8); }
    const bf16* WWT = (const bf16*)(p.ws + WS_WWBT); const bf16* WAT = (const bf16*)(p.ws + WS_WABT);
#pragma unroll 1
    for (int hp = 0; hp < 2; ++hp) {
        {
            const int chb = hp * 512 + wave * 64;
            bf16x8 bw[4][2], ba[4][2];
#pragma unroll
            for (int n = 0; n < 4; ++n)
#pragma unroll
                for (int ks = 0; ks < 2; ++ks) { bw[n][ks] = *(const bf16x8*)(WWT + (size_t)(chb + n * 16 + fr) * 64 + ks * 32 + fq * 8); ba[n][ks] = *(const bf16x8*)(WAT + (size_t)(chb + n * 16 + fr) * 64 + ks * 32 + fq * 8); }
            __builtin_amdgcn_sched_barrier(0);
#pragma unroll
            for (int n = 0; n < 4; ++n) {
                f32x4 cw = (f32x4){0.f, 0.f, 0.f, 0.f}, ca = (f32x4){0.f, 0.f, 0.f, 0.f};
#pragma unroll
                for (int ks = 0; ks < 2; ++ks) { cw = __builtin_amdgcn_mfma_f32_16x16x32_bf16(aw[ks], bw[n][ks], cw, 0, 0, 0); ca = __builtin_amdgcn_mfma_f32_16x16x32_bf16(aa[ks], ba[n][ks], ca, 0, 0, 0); }
#pragma unroll
                for (int r = 0; r < 4; ++r) { lw[(4 * fq + r) * 512 + wave * 64 + n * 16 + fr] = cw[r]; la[(4 * fq + r) * 512 + wave * 64 + n * 16 + fr] = ca[r]; }
            }
        }
        __syncthreads();
#pragma unroll 1
        for (int it2 = 0; it2 < 2; ++it2) {
            f32x4 r4[2], k4[2], v4[2];
#pragma unroll
            for (int u = 0; u < 2; ++u) {
                const int e = (it2 * 2 + u) * 512 + tid, tok = e >> 7, ch = hp * 512 + (e & 127) * 4, row = row0 + tok;
                r4[u] = za_xs4(p, ZA, row, ch); k4[u] = za_xs4(p, ZA, row, 1024 + ch); v4[u] = za_xs4(p, ZA, row, 2048 + ch);
            }
            __builtin_amdgcn_sched_barrier(0);
#pragma unroll
            for (int u = 0; u < 2; ++u) {
                const int e = (it2 * 2 + u) * 512 + tid, tok = e >> 7, chl = (e & 127) * 4, ch = hp * 512 + chl, h = ch >> 6, c4 = ch & 63, row = row0 + tok;
                const f32x4 lwv = *(LAS const f32x4*)(lw + tok * 512 + chl) + *(const f32x4*)(p.in[I_W0] + ch);
                const f32x4 lav = *(LAS const f32x4*)(la + tok * 512 + chl) + *(const f32x4*)(p.in[I_A0] + ch);
                const f32x4 kkw = *(const f32x4*)(p.in[I_KK] + ch), kaw = *(const f32x4*)(p.in[I_KA] + ch);
                f32x4 dec, av, kk, k2;
#pragma unroll
                for (int i = 0; i < 4; ++i) {
                    const float nx = -lwv[i];
                    const float sp = fmaxf(nx, 0.f) + __logf(1.f + __expf(-fabsf(nx)));
                    dec[i] = __expf(-__expf(-sp - 0.5f));
                    av[i] = 1.f / (1.f + __expf(-lav[i]));
                    kk[i] = k4[u][i] * kkw[i];
                    k2[i] = k4[u][i] * (1.f + (av[i] - 1.f) * kaw[i]);
                }
                const float nrm = fmaxf(sqrtf(row16_sum((kk.x * kk.x + kk.y * kk.y) + (kk.z * kk.z + kk.w * kk.w))), 1e-12f);
                kk = kk * (1.f / nrm);
                float* base = row < MP ? (float*)(p.ws + WS_OPS) + ((size_t)((row >> 11) * 16 + h) * 2048 + (row & 2047)) * 384
                                       : (float*)(p.ws + WS_OPSS) + ((size_t)(row - MP) * 16 + h) * 384;
                *(f32x4*)(base + c4) = dec; *(f32x4*)(base + 64 + c4) = -kk; *(f32x4*)(base + 128 + c4) = kk * av; *(f32x4*)(base + 192 + c4) = k2; *(f32x4*)(base + 256 + c4) = r4[u]; *(f32x4*)(base + 320 + c4) = v4[u];
            }
        }
        __syncthreads();
    }
}
constexpr int CH_X1 = 0, CH_X2 = 4096, CH_X3 = 5120, CH_WC = 9216, CH_VP = 9472, CH_BYTES = 12288;
__device__ __forceinline__ float wave64_sum(float x) { x = row16_sum(x); x += __shfl_xor(x, 16); x += __shfl_xor(x, 32); return x; }
__device__ __forceinline__ void prompt_head(const Params& p, int row0, int h, LAS unsigned char* scr, const bf16x8 (&aw)[2], const bf16x8 (&aa)[2], int lane) {
    const int fr = lane & 15, fq = lane >> 4, c = lane, ch = h * 64 + c;
    const int b = row0 >> 11, t0 = row0 & 2047, bh = b * 16 + h;
    const bf16* ZA = (const bf16*)(p.ws + WS_ZA);
    unsigned short zr_[16], zk_[16], zv_[16];
#pragma unroll
    for (int t = 0; t < 16; ++t) { const bf16* z = ZA + (size_t)(row0 + t) * ASH + ch; zr_[t] = z[0]; zk_[t] = z[1024]; zv_[t] = z[2048]; }
    LAS float* lwla = (LAS float*)scr;
    {
        const bf16* WWT = (const bf16*)(p.ws + WS_WWBT) + (size_t)(h * 64 + fr) * 64 + fq * 8; const bf16* WAT = (const bf16*)(p.ws + WS_WABT) + (size_t)(h * 64 + fr) * 64 + fq * 8;
        bf16x8 bw[4][2], ba[4][2];
#pragma unroll
        for (int n = 0; n < 4; ++n)
#pragma unroll
            for (int ks = 0; ks < 2; ++ks) { bw[n][ks] = *(const bf16x8*)(WWT + n * 1024 + ks * 32); ba[n][ks] = *(const bf16x8*)(WAT + n * 1024 + ks * 32); }
#pragma unroll
        for (int n = 0; n < 4; ++n) {
            f32x4 cw = (f32x4){0.f, 0.f, 0.f, 0.f}, ca = (f32x4){0.f, 0.f, 0.f, 0.f};
#pragma unroll
            for (int ks = 0; ks < 2; ++ks) { cw = __builtin_amdgcn_mfma_f32_16x16x32_bf16(aw[ks], bw[n][ks], cw, 0, 0, 0); ca = __builtin_amdgcn_mfma_f32_16x16x32_bf16(aa[ks], ba[n][ks], ca, 0, 0, 0); }
#pragma unroll
            for (int r = 0; r < 4; ++r) { lwla[(4 * fq + r) * 64 + n * 16 + fr] = cw[r]; lwla[1024 + (4 * fq + r) * 64 + n * 16 + fr] = ca[r]; }
        }
    }
    const float w0 = p.in[I_W0][ch], a0 = p.in[I_A0][ch], kkw = p.in[I_KK][ch], kaw = p.in[I_KA][ch];
    const float mur = p.in[I_MU][ch], muk = p.in[I_MU][1024 + ch], muv = p.in[I_MU][2048 + ch];
    float pr = 0.f, pk = 0.f, pv = 0.f;
    if (t0) { const bf16* zp = ZA + (size_t)(row0 - 1) * ASH + ch; pr = bf2f(zp[0]); pk = bf2f(zp[1024]); pv = bf2f(zp[2048]); }
    float At[16], Rt[16], Bt[16], Kt[16], Vt[16];
    float Wc = 1.f;
    bf16* vbp = (bf16*)(p.ws + WS_OPSA) + (size_t)row0 * DA + ch;
    const float rkw = p.in[I_RK][ch];
#pragma unroll
    for (int tb = 0; tb < 16; tb += 4) {
    float fr_[4], fk_[4], fv_[4];
#pragma unroll
    for (int t = 0; t < 4; ++t) { fr_[t] = bf2f(zr_[tb + t]); fk_[t] = bf2f(zk_[tb + t]); fv_[t] = bf2f(zv_[tb + t]); }
#pragma unroll
    for (int tt = 0; tt < 4; ++tt) {
        const int t = tb + tt;
        const float xr = fr_[tt] + mur * (pr - fr_[tt]), xk = fk_[tt] + muk * (pk - fk_[tt]), xv = fv_[tt] + muv * (pv - fv_[tt]);
        pr = fr_[tt]; pk = fk_[tt]; pv = fv_[tt];
        const float lwv = lwla[t * 64 + c] + w0, lav = lwla[1024 + t * 64 + c] + a0;
        const float nx = -lwv;
        const float sp = fmaxf(nx, 0.f) + __logf(1.f + __expf(-fabsf(nx)));
        const float dec = __expf(-__expf(-sp - 0.5f));
        const float av = __builtin_amdgcn_rcpf(1.f + __expf(-lav));
        float kk = xk * kkw;
        const float nrm = fmaxf(__builtin_amdgcn_sqrtf(wave64_sum(kk * kk)), 1e-12f);
        kk = kk * __builtin_amdgcn_rcpf(nrm);
        const float k2 = xk * (1.f + (av - 1.f) * kaw);
        const float Wprev = Wc; Wc *= dec;
        const float inv = __builtin_amdgcn_rcpf(Wc);
        At[t] = -kk * Wprev; Rt[t] = xr * Wc; Bt[t] = kk * av * inv; Kt[t] = k2 * inv; Vt[t] = xv;
        { const float bs = wave64_sum(xr * k2 * rkw); vbp[(size_t)t * DA] = (bf16)f2bf(xv * bs); }
    }
    __builtin_amdgcn_sched_barrier(0);
    }
    __builtin_amdgcn_sched_barrier(0);
    LAS bf16* ARt = (LAS bf16*)scr; LAS bf16* BKt = ARt + 32 * 64;
#pragma unroll
    for (int t = 0; t < 16; ++t) { ARt[t * 64 + c] = (bf16)f2bf(At[t]); ARt[(16 + t) * 64 + c] = (bf16)f2bf(Rt[t]); BKt[t * 64 + c] = (bf16)f2bf(Bt[t]); BKt[(16 + t) * 64 + c] = (bf16)f2bf(Kt[t]); }
    unsigned char* rec = p.ws + WS_CH + ((size_t)bh * 128 + (t0 >> 4)) * CH_BYTES;
    {
        u32x4* x3 = (u32x4*)(rec + CH_X3);
#pragma unroll
        for (int f = 0; f < 4; ++f) {
            u32x4 w; w.x = pk2(Bt[4 * f], Bt[4 * f + 1]); w.y = pk2(Bt[4 * f + 2], Bt[4 * f + 3]); w.z = pk2(Kt[4 * f], Kt[4 * f + 1]); w.w = pk2(Kt[4 * f + 2], Kt[4 * f + 3]);
            x3[((c >> 4) * 4 + f) * 16 + (c & 15)] = w;
        }
        ((float*)(rec + CH_WC))[((c >> 2) & 3) * 16 + (c >> 4) * 4 + (c & 3)] = Wc;
        unsigned long long* vp = (unsigned long long*)(rec + CH_VP);
#pragma unroll
        for (int f = 0; f < 4; ++f) vp[f * 64 + c] = (unsigned long long)pk2(Vt[4 * f], Vt[4 * f + 1]) | ((unsigned long long)pk2(Vt[4 * f + 2], Vt[4 * f + 3]) << 32);
    }
    f32x4 D[2][2];
    {
        bf16x8 fa[2][2], fb[2][2];
#pragma unroll
        for (int m = 0; m < 2; ++m)
#pragma unroll
            for (int ks = 0; ks < 2; ++ks) { fa[m][ks] = *(LAS const bf16x8*)(BKt + (m * 16 + fr) * 64 + ks * 32 + fq * 8); fb[m][ks] = *(LAS const bf16x8*)(ARt + (m * 16 + fr) * 64 + ks * 32 + fq * 8); }
#pragma unroll
        for (int m = 0; m < 2; ++m)
#pragma unroll
            for (int n = 0; n < 2; ++n) {
                f32x4 d = (f32x4){0.f, 0.f, 0.f, 0.f};
#pragma unroll
                for (int ks = 0; ks < 2; ++ks) d = __builtin_amdgcn_mfma_f32_16x16x32_bf16(fa[m][ks], fb[n][ks], d, 0, 0, 0);
                D[m][n] = d;
            }
    }
    asm volatile("s_waitcnt lgkmcnt(0)" ::: "memory");
    LAS float* Mab = (LAS float*)scr; LAS float* Mak = Mab + 256; LAS float* Mbr = Mab + 512; LAS float* Mkr = Mab + 768; LAS float* Tm = Mab + 1024; LAS float* P1m = Mab + 1280;
#pragma unroll
    for (int r = 0; r < 4; ++r) {
        const int i = 4 * fq + r, t = fr;
        Mab[i * 16 + t] = i < t ? D[0][0][r] : 0.f; Mbr[i * 16 + t] = i <= t ? D[0][1][r] : 0.f;
        Mak[i * 16 + t] = i < t ? D[1][0][r] : 0.f; Mkr[i * 16 + t] = i <= t ? D[1][1][r] : 0.f;
    }
    __builtin_amdgcn_sched_barrier(0);
    {
        float Tj[16];
#pragma unroll
        for (int t = 0; t < 16; ++t) Tj[t] = (fr == t) ? 1.f : 0.f;
#pragma unroll
        for (int i = 0; i < 15; ++i) {
            float row[16];
#pragma unroll
            for (int q4 = 0; q4 < 4; ++q4) { const f32x4 v = *(LAS const f32x4*)(Mab + i * 16 + q4 * 4); row[q4 * 4] = v.x; row[q4 * 4 + 1] = v.y; row[q4 * 4 + 2] = v.z; row[q4 * 4 + 3] = v.w; }
#pragma unroll
            for (int t = i + 1; t < 16; ++t) Tj[t] += Tj[i] * row[t];
        }
        if (lane < 16) {
#pragma unroll
            for (int q4 = 0; q4 < 4; ++q4) *(LAS f32x4*)(Tm + lane * 16 + q4 * 4) = (f32x4){Tj[q4 * 4], Tj[q4 * 4 + 1], Tj[q4 * 4 + 2], Tj[q4 * 4 + 3]};
        }
    }
    {
        const int i = fr, tq = fq;
        f32x4 p1 = (f32x4){0.f, 0.f, 0.f, 0.f};
#pragma unroll
        for (int j = 0; j < 16; ++j) p1 += *(LAS const f32x4*)(Tm + j * 16 + tq * 4) * Mak[i * 16 + j];
        *(LAS f32x4*)(P1m + i * 16 + tq * 4) = p1;
        f32x4 g = *(LAS const f32x4*)(Mkr + i * 16 + tq * 4);
#pragma unroll
        for (int j = 0; j < 16; ++j) g += *(LAS const f32x4*)(Mbr + j * 16 + tq * 4) * P1m[i * 16 + j];
        bf16* x2 = (bf16*)(rec + CH_X2);
#pragma unroll
        for (int jj = 0; jj < 4; ++jj) {
            x2[(((i >> 2)) * 16 + 4 * tq + jj) * 4 + (i & 3)] = (bf16)f2bf(p1[jj]);
            x2[((4 + (i >> 2)) * 16 + 4 * tq + jj) * 4 + (i & 3)] = (bf16)f2bf(g[jj]);
        }
    }
    __builtin_amdgcn_sched_barrier(0);
    {
        const int k = c, ks = k >> 5, j = ((k >> 4) & 1) * 4 + (k & 3), fqk = (k >> 2) & 3;
        bf16* x1 = (bf16*)(rec + CH_X1) + ((ks * 4 + fqk) * 32) * 8 + j;
        float Qh[16];
#pragma unroll
        for (int t = 0; t < 16; ++t) Qh[t] = Rt[t];
#pragma unroll 1
        for (int t = 0; t < 16; ++t) {
            float at = 0.f;
#pragma unroll
            for (int i = 0; i < 16; ++i) at += At[i] * Tm[i * 16 + t];
            x1[t * 8] = (bf16)f2bf(at);
#pragma unroll
            for (int q4 = 0; q4 < 4; ++q4) { const f32x4 v = *(LAS const f32x4*)(Mbr + t * 16 + q4 * 4); Qh[q4 * 4] += at * v.x; Qh[q4 * 4 + 1] += at * v.y; Qh[q4 * 4 + 2] += at * v.z; Qh[q4 * 4 + 3] += at * v.w; }
        }
#pragma unroll
        for (int t = 0; t < 16; ++t) x1[(16 + t) * 8] = (bf16)f2bf(Qh[t]);
    }
    asm volatile("s_waitcnt lgkmcnt(0)" ::: "memory");
}
__device__ __forceinline__ void prompt_item(const Params& p, int item, LAS unsigned char* lds, const int tid_) {
    const int tid = tid_, wave = __builtin_amdgcn_readfirstlane(tid >> 6), lane = tid & 63, fr = lane & 15, fq = lane >> 4;
    const int row0 = item * 16;
    const bf16* ZA = (const bf16*)(p.ws + WS_ZA);
    LAS bf16* xwb = (LAS bf16*)(lds + 65536); LAS bf16* xab = xwb + 16 * 72;
    {
        const int tok = tid >> 5, j4 = (tid & 31) * 4;
        const f32x4 xs = za_xs4(p, ZA, row0 + tok, 3072 + j4);
        if (j4 < 64) *(LAS unsigned long long*)(xwb + tok * 72 + j4) = (unsigned long long)pk2(tanhf(xs.x), tanhf(xs.y)) | ((unsigned long long)pk2(tanhf(xs.z), tanhf(xs.w)) << 32);
        else *(LAS unsigned long long*)(xab + tok * 72 + j4 - 64) = (unsigned long long)pk2(xs.x, xs.y) | ((unsigned long long)pk2(xs.z, xs.w) << 32);
    }
    __syncthreads();
    bf16x8 aw[2], aa[2];
#pragma unroll
    for (int ks = 0; ks < 2; ++ks) { aw[ks] = *(LAS const bf16x8*)(xwb + fr * 72 + ks * 32 + fq * 8); aa[ks] = *(LAS const bf16x8*)(xab + fr * 72 + ks * 32 + fq * 8); }
#pragma unroll 1
    for (int hh = 0; hh < 2; ++hh) prompt_head(p, row0, wave * 2 + hh, lds + wave * 8192, aw, aa, lane);
    __syncthreads();
}
__device__ __forceinline__ void tr_item(const Params& p, int item, LAS unsigned char* lds, const int tid_) {
    const int tid = tid_;
    const int which = item & 1, tt = (item >> 1) & 31, bh = item >> 6, b = bh >> 2, h = bh & 3;
    const bf16* ZB = (const bf16*)(p.ws + WS_ZB);
    LAS bf16* tile = (LAS bf16*)lds;
    const int t0 = tt * 64;
    const float lg = logf(gamma_h(h));
    for (int e = tid; e < 2048; e += 512) {
        const int t = e >> 5, dc = e & 31;
        const u32x4 w = *(const u32x4*)(ZB + (size_t)(b * 2048 + t0 + t) * ZBW + (which ? ZB_V : ZB_K) + h * 256 + dc * 8);
        unsigned ww[4] = {w.x, w.y, w.z, w.w};
        float sc = 1.f;
        if (!which) sc = expf((float)(127 - ((t0 + t) & 127)) * lg);
#pragma unroll
        for (int i = 0; i < 4; ++i) {
            tile[t * 258 + dc * 8 + 2 * i] = (bf16)f2bf(bflo(ww[i]) * sc);
            tile[t * 258 + dc * 8 + 2 * i + 1] = (bf16)f2bf(bfhi(ww[i]) * sc);
        }
    }
    __syncthreads();
    bf16* dst = (bf16*)(p.ws + (which ? WS_VT : WS_KDT)) + (size_t)bh * 256 * 2048;
    for (int e = tid; e < 2048; e += 512) {
        const int d = e >> 3, tc = e & 7;
        unsigned o[4];
#pragma unroll
        for (int i = 0; i < 4; ++i) o[i] = (unsigned)tile[(tc * 8 + 2 * i) * 258 + d] | ((unsigned)tile[(tc * 8 + 2 * i + 1) * 258 + d] << 16);
        u32x4 w; w.x = o[0]; w.y = o[1]; w.z = o[2]; w.w = o[3];
        *(u32x4*)(dst + (size_t)d * 2048 + t0 + tc * 8) = w;
    }
    __syncthreads();
}
__device__ __forceinline__ void phase2(const Params& p, LAS unsigned char* lds, const int tid_) {
    for (int it = blockIdx.x; it < 512; it += gridDim.x) prompt_item(p, it, lds, tid_);
    if (gridDim.x > 16) {
        if (blockIdx.x < 8) prep_item(p, 512 + blockIdx.x, lds, tid_);
        else for (int it = blockIdx.x - 8; it < 1024; it += gridDim.x - 8) tr_item(p, it, lds, tid_);
    } else {
        for (int it = 512 + blockIdx.x; it < 520; it += gridDim.x) prep_item(p, it, lds, tid_);
        for (int it = blockIdx.x; it < 1024; it += gridDim.x) tr_item(p, it, lds, tid_);
    }
    const bf16* ZA = (const bf16*)(p.ws + WS_ZA);
    const int gt = blockIdx.x * 512 + tid_, NT = gridDim.x * 512;
    for (int e = gt; e < 4 * ASH; e += NT) { const int b = e / ASH, c = e % ASH; p.out[O_SHP + e] = bf2f(ZA[(size_t)(b * 2048 + 2047) * ASH + c]); }
    for (int e = gt; e < MS * ASH; e += NT) { p.out[O_SHS + e] = bf2f(ZA[(size_t)MP * ASH + e]); }
}

constexpr int CR_NS = 8, CR_FULL = CR_NS * CH_BYTES, CR_DONE = CR_FULL + 64;
#define GLDS16(src, dst) __builtin_amdgcn_global_load_lds((const unsigned*)(src), (LAS unsigned*)(dst), 16, 0, 0)
__device__ __forceinline__ void chunk_loader(const unsigned char* rec, LAS unsigned char* lds, int lw, int lane) {
    LAS unsigned* FULL = (LAS unsigned*)(lds + CR_FULL); volatile LAS unsigned* DONE = (volatile LAS unsigned*)(lds + CR_DONE);
    int pub = 0;
    for (int q = 0; q < 128; ++q) {
        const int s = q % CR_NS;
        if (q >= CR_NS) {
            const unsigned need = 4u * (unsigned)(q / CR_NS);
            if (DONE[s] < need && pub < q) { asm volatile("s_waitcnt vmcnt(0)" ::: "memory"); for (; pub < q; ++pub) { if (lane == 0) __hip_atomic_fetch_add(FULL + pub % CR_NS, 1u, __ATOMIC_RELAXED, __HIP_MEMORY_SCOPE_WORKGROUP); } }
            while (DONE[s] < need) __builtin_amdgcn_s_sleep(1);
            __builtin_amdgcn_fence(__ATOMIC_ACQUIRE, "workgroup");
        }
        const unsigned char* src = rec + (size_t)q * CH_BYTES + lw * 3072 + lane * 16;
        LAS unsigned char* dst = lds + s * CH_BYTES + lw * 3072;
#pragma unroll
        for (int i = 0; i < 3; ++i) GLDS16(src + i * 1024, dst + i * 1024);
        if (q >= 5 && pub < q - 4) { asm volatile("s_waitcnt vmcnt(15)" ::: "memory"); if (lane == 0) __hip_atomic_fetch_add(FULL + pub % CR_NS, 1u, __ATOMIC_RELAXED, __HIP_MEMORY_SCOPE_WORKGROUP); ++pub; }
    }
    asm volatile("s_waitcnt vmcnt(0)" ::: "memory");
    for (; pub < 128; ++pub) { if (lane == 0) __hip_atomic_fetch_add(FULL + pub % CR_NS, 1u, __ATOMIC_RELAXED, __HIP_MEMORY_SCOPE_WORKGROUP); }
}
__device__ __forceinline__ void chunk_scan(const Params& p, int bh, int wv, int lane, LAS unsigned char* lds) {
    const int fr = lane & 15, fq = lane >> 4, b = bh >> 4, h = bh & 15;
    volatile LAS unsigned* FULL = (volatile LAS unsigned*)(lds + CR_FULL); LAS unsigned* DONE = (LAS unsigned*)(lds + CR_DONE);
    float* yp = (float*)(p.ws + WS_YA) + (size_t)(b * 2048 + 4 * fq) * DA + h * 64 + wv * 16 + fr;
    f32x4 S[4];
#pragma unroll
    for (int m = 0; m < 4; ++m) S[m] = (f32x4){0.f, 0.f, 0.f, 0.f};
#pragma unroll 1
    for (int ck = 0; ck < 128; ++ck) {
        const int s = ck % CR_NS;
        const unsigned need = 4u * (unsigned)(ck / CR_NS + 1);
        while (FULL[s] < need) {}
        __builtin_amdgcn_fence(__ATOMIC_ACQUIRE, "workgroup");
        LAS const unsigned char* r_ = lds + s * CH_BYTES;
        bf16x8 X1[2][2], X3[4]; unsigned long long X2[2], V4; f32x4 Wc[4];
#pragma unroll
        for (int mt = 0; mt < 2; ++mt)
#pragma unroll
            for (int ks = 0; ks < 2; ++ks) X1[mt][ks] = *(LAS const bf16x8*)(r_ + CH_X1 + (((ks * 4 + fq) * 32 + mt * 16 + fr) * 8) * 2);
#pragma unroll
        for (int mt = 0; mt < 2; ++mt) X2[mt] = *(LAS const unsigned long long*)(r_ + CH_X2 + (((mt * 4 + fq) * 16 + fr) * 4) * 2);
#pragma unroll
        for (int mt = 0; mt < 4; ++mt) X3[mt] = *(LAS const bf16x8*)(r_ + CH_X3 + (((mt * 4 + fq) * 16 + fr) * 8) * 2);
#pragma unroll
        for (int mt = 0; mt < 4; ++mt) Wc[mt] = *(LAS const f32x4*)(r_ + CH_WC + (fq * 16 + mt * 4) * 4);
        V4 = *(LAS const unsigned long long*)(r_ + CH_VP + ((fq * 64 + wv * 16 + fr) * 4) * 2);
        bf16x8 Sb[2], Vb, X2f[2];
#pragma unroll
        for (int ks = 0; ks < 2; ++ks) {
            u32x4 w; w.x = pk2(S[2 * ks].x, S[2 * ks].y); w.y = pk2(S[2 * ks].z, S[2 * ks].w); w.z = pk2(S[2 * ks + 1].x, S[2 * ks + 1].y); w.w = pk2(S[2 * ks + 1].z, S[2 * ks + 1].w);
            Sb[ks] = __builtin_bit_cast(bf16x8, w);
        }
        { u32x4 w; w.x = (unsigned)V4; w.y = (unsigned)(V4 >> 32); w.z = 0u; w.w = 0u; Vb = __builtin_bit_cast(bf16x8, w); }
#pragma unroll
        for (int mt = 0; mt < 2; ++mt) { u32x4 w; w.x = (unsigned)X2[mt]; w.y = (unsigned)(X2[mt] >> 32); w.z = 0u; w.w = 0u; X2f[mt] = __builtin_bit_cast(bf16x8, w); }
        asm volatile("s_waitcnt lgkmcnt(0)" ::: "memory");
        if (lane == 0) __hip_atomic_fetch_add(DONE + s, 1u, __ATOMIC_RELAXED, __HIP_MEMORY_SCOPE_WORKGROUP);
        f32x4 D1[2];
#pragma unroll
        for (int mt = 0; mt < 2; ++mt) {
            f32x4 d = (f32x4){0.f, 0.f, 0.f, 0.f};
            d = __builtin_amdgcn_mfma_f32_16x16x32_bf16(X1[mt][0], Sb[0], d, 0, 0, 0);
            d = __builtin_amdgcn_mfma_f32_16x16x32_bf16(X1[mt][1], Sb[1], d, 0, 0, 0);
            d = __builtin_amdgcn_mfma_f32_16x16x32_bf16(X2f[mt], Vb, d, 0, 0, 0);
            D1[mt] = d;
        }
        bf16x8 SAV;
        { u32x4 w; w.x = pk2(D1[0].x, D1[0].y); w.y = pk2(D1[0].z, D1[0].w); w.z = (unsigned)V4; w.w = (unsigned)(V4 >> 32); SAV = __builtin_bit_cast(bf16x8, w); }
        f32x4 D2[4];
#pragma unroll
        for (int mt = 0; mt < 4; ++mt) D2[mt] = __builtin_amdgcn_mfma_f32_16x16x32_bf16(X3[mt], SAV, (f32x4){0.f, 0.f, 0.f, 0.f}, 0, 0, 0);
#pragma unroll
        for (int mt = 0; mt < 4; ++mt) S[mt] = (S[mt] + D2[mt]) * Wc[mt];
        float* y = yp + (size_t)ck * 16 * DA;
        y[0] = D1[1].x; y[DA] = D1[1].y; y[2 * DA] = D1[1].z; y[3 * DA] = D1[1].w;
    }
#pragma unroll
    for (int mt = 0; mt < 4; ++mt) *(f32x4*)(p.out + O_WKVP + ((size_t)bh * 64 + wv * 16 + fr) * 64 + mt * 16 + 4 * fq) = S[mt];
}
__device__ __forceinline__ void stepA_task(const Params& p, int task, int lane) {
    const int bh = task >> 6, dt = (task >> 2) & 15, vq = task & 3, fr = lane & 15, fq = lane >> 4, h = bh & 3;
    const bf16* KT = (const bf16*)(p.ws + WS_KDT) + (size_t)bh * 256 * 2048 + (size_t)(dt * 16 + fr) * 2048 + fq * 8;
    const bf16* VT = (const bf16*)(p.ws + WS_VT) + (size_t)bh * 256 * 2048 + (size_t)(vq * 64 + fr) * 2048 + fq * 8;
    bf16* ST = (bf16*)(p.ws + WS_ST) + ((size_t)(bh * 16) << 16) + (size_t)(vq * 64 + fr) * 256 + dt * 16 + 4 * fq;
    const float g128 = gpow(h, 128.f);
    f32x4 acc[4];
#pragma unroll
    for (int n = 0; n < 4; ++n) acc[n] = (f32x4){0.f, 0.f, 0.f, 0.f};
    bf16x8 FA[8], FB[8][4];
#define SA_LOAD(u_, s_) do { const bf16* ka_ = KT + (s_) * 32; const bf16* vb_ = VT + (s_) * 32; FA[u_] = *(const bf16x8*)ka_; \
        _Pragma("unroll") for (int n = 0; n < 4; ++n) FB[u_][n] = *(const bf16x8*)(vb_ + (size_t)(n * 16) * 2048); } while (0)
#pragma unroll
    for (int u = 0; u < 8; ++u) SA_LOAD(u, u);
#pragma unroll 1
    for (int g = 0; g < 8; ++g) {
#pragma unroll
        for (int u = 0; u < 8; ++u) {
            const int s = g * 8 + u;
            if ((u & 3) == 0) {
                bf16* st = ST + ((size_t)(s >> 2) << 16);
#pragma unroll
                for (int n = 0; n < 4; ++n) {
                    *(unsigned long long*)(st + (size_t)(n * 16) * 256) = (unsigned long long)pk2(acc[n].x, acc[n].y) | ((unsigned long long)pk2(acc[n].z, acc[n].w) << 32);
                    acc[n] = acc[n] * g128;
                }
            }
#pragma unroll
            for (int n = 0; n < 4; ++n) acc[n] = __builtin_amdgcn_mfma_f32_16x16x32_bf16(FA[u], FB[u][n], acc[n], 0, 0, 0);
            { const int sn = s + 8 < 64 ? s + 8 : 63; SA_LOAD(u, sn); }
        }
    }
#undef SA_LOAD
    float* o = p.out + O_RETP + ((size_t)bh << 16) + (size_t)(dt * 16 + 4 * fq) * 256 + vq * 64 + fr;
#pragma unroll
    for (int n = 0; n < 4; ++n)
#pragma unroll
        for (int r = 0; r < 4; ++r) o[(size_t)r * 256 + n * 16] = acc[n][r];
}
__device__ __forceinline__ void wkv_sample_unit(const Params& p, int su, int lane) {
    const float* o = (const float*)(p.ws + WS_OPSS) + (size_t)su * 384;
    const int kq = (lane & 15) * 4, rq = lane >> 4;
    const f32x4* S0 = (const f32x4*)(p.in[I_SWKV] + (size_t)su * 4096) + lane; f32x4* Sn = (f32x4*)(p.out + O_WKVS + (size_t)su * 4096) + lane;
    f32x4 S[16]; float vv[16];
#pragma unroll
    for (int i = 0; i < 16; ++i) { S[i] = S0[i * 64]; vv[i] = o[320 + i * 4 + rq]; }
    const f32x4 w4 = *(const f32x4*)(o + kq), a4 = *(const f32x4*)(o + 64 + kq), b4 = *(const f32x4*)(o + 128 + kq), k4 = *(const f32x4*)(o + 192 + kq), r4 = *(const f32x4*)(o + 256 + kq);
    const int s = su >> 4, h = su & 15;
    float* ya = (float*)(p.ws + WS_YA) + (size_t)(MP + s) * DA + h * 64 + rq;
#pragma unroll
    for (int i = 0; i < 16; ++i) {
        const float dot = row16_sum((S[i].x * a4.x + S[i].y * a4.y) + (S[i].z * a4.z + S[i].w * a4.w));
        const f32x4 sn = S[i] * w4 + b4 * dot + k4 * vv[i];
        Sn[i * 64] = sn;
        const float y = row16_sum((sn.x * r4.x + sn.y * r4.y) + (sn.z * r4.z + sn.w * r4.w));
        if ((lane & 15) == 0) ya[i * 4] = y;
    }
}
__device__ __forceinline__ void ret_sample_task(const Params& p, int su, int lane) {
    const int s = su >> 2, h = su & 3, row = MP + s;
    const bf16* zr = (const bf16*)(p.ws + WS_ZB) + (size_t)row * ZBW;
    const unsigned long long qw = *(const unsigned long long*)(zr + ZB_Q + h * 256 + lane * 4), kw = *(const unsigned long long*)(zr + ZB_K + h * 256 + lane * 4),
                             vw = *(const unsigned long long*)(zr + ZB_V + h * 256 + lane * 4), gw = *(const unsigned long long*)(zr + ZB_G + h * 256 + lane * 4);
    const float q4[4] = {bflo((unsigned)qw), bfhi((unsigned)qw), bflo((unsigned)(qw >> 32)), bfhi((unsigned)(qw >> 32))};
    const float k4[4] = {bflo((unsigned)kw), bfhi((unsigned)kw), bflo((unsigned)(kw >> 32)), bfhi((unsigned)(kw >> 32))};
    const f32x4 vv = (f32x4){bflo((unsigned)vw), bfhi((unsigned)vw), bflo((unsigned)(vw >> 32)), bfhi((unsigned)(vw >> 32))};
    const f32x4 gg = (f32x4){bflo((unsigned)gw), bfhi((unsigned)gw), bflo((unsigned)(gw >> 32)), bfhi((unsigned)(gw >> 32))};
    const float qk = wave_sum((q4[0] * k4[0] + q4[1] * k4[1]) + (q4[2] * k4[2] + q4[3] * k4[3]));
    const float gam = gamma_h(h);
    const f32x4* S0 = (const f32x4*)(p.in[I_SRET] + (size_t)su * 65536) + lane; f32x4* Sn = (f32x4*)(p.out + O_RETS + (size_t)su * 65536) + lane;
    f32x4 acc = (f32x4){0.f, 0.f, 0.f, 0.f};
    f32x4 cur[16], nxt[16];
#pragma unroll
    for (int e = 0; e < 16; ++e) cur[e] = S0[(size_t)e * 64];
#pragma unroll 1
    for (int l0 = 0; l0 < 64; l0 += 4) {
        const int ln = l0 + 4 < 64 ? l0 + 4 : l0;
#pragma unroll
        for (int e = 0; e < 16; ++e) nxt[e] = S0[(size_t)(ln * 4 + e) * 64];
        __builtin_amdgcn_sched_barrier(0);
#pragma unroll
        for (int e = 0; e < 16; ++e) {
            const int l = l0 + (e >> 2), j = e & 3;
            const float qd = __builtin_bit_cast(float, __builtin_amdgcn_readlane(__builtin_bit_cast(int, q4[j]), l));
            const float kd = __builtin_bit_cast(float, __builtin_amdgcn_readlane(__builtin_bit_cast(int, k4[j]), l));
            acc += cur[e] * qd;
            Sn[(size_t)(l0 * 4 + e) * 64] = cur[e] * gam + vv * kd;
        }
        __builtin_amdgcn_sched_barrier(0);
#pragma unroll
        for (int e = 0; e < 16; ++e) cur[e] = nxt[e];
    }
    const f32x4 o = vv * qk + acc * gam;
    const float mean = wave_sum((o.x + o.y) + (o.z + o.w)) * (1.f / 256.f);
    const f32x4 oc = o - mean;
    const float var = wave_sum((oc.x * oc.x + oc.y * oc.y) + (oc.z * oc.z + oc.w * oc.w)) * (1.f / 256.f);
    const float rstd = 1.f / sqrtf(var + 1e-5f);
    const f32x4 g4 = ((const f32x4*)(p.in[I_GBG] + h * 256))[lane], b4 = ((const f32x4*)(p.in[I_GBB] + h * 256))[lane];
    const f32x4 yn = oc * rstd * g4 + b4;
    *(unsigned long long*)((bf16*)(p.ws + WS_MIX) + (size_t)row * DM + DA + h * 256 + lane * 4) =
        (unsigned long long)pk2(yn.x * siluf_(gg.x), yn.y * siluf_(gg.y)) | ((unsigned long long)pk2(yn.z * siluf_(gg.z), yn.w * siluf_(gg.w)) << 32);
}
__device__ __forceinline__ void ret_sample_unit(const Params& p, int su, LAS unsigned char* lds, const int tid_) {
    const int tid = tid_, wave = tid >> 6, lane = tid & 63;
    const int s = su >> 2, h = su & 3, row = MP + s;
    const bf16* zr = (const bf16*)(p.ws + WS_ZB) + (size_t)row * ZBW;
    LAS float* qs = (LAS float*)lds; LAS float* ks = qs + 256; LAS float* red = ks + 256;
    LAS float* st = red + 2048;
    if (tid < 256) { qs[tid] = bf2f(zr[ZB_Q + h * 256 + tid]); ks[tid] = bf2f(zr[ZB_K + h * 256 + tid]); }
    __syncthreads();
    float qk = 0.f;
#pragma unroll
    for (int j = 0; j < 4; ++j) qk += qs[lane * 4 + j] * ks[lane * 4 + j];
    qk = wave_sum(qk);
    const float gam = gamma_h(h);
    const int vq = lane, dp = wave;
    f32x4 vv; { const bf16* vp = zr + ZB_V + h * 256 + vq * 4; vv = (f32x4){bf2f(vp[0]), bf2f(vp[1]), bf2f(vp[2]), bf2f(vp[3])}; }
    const float* S0 = p.in[I_SRET] + (size_t)su * 65536; float* Sn = p.out + O_RETS + (size_t)su * 65536;
    f32x4 acc = (f32x4){0.f, 0.f, 0.f, 0.f};
#pragma unroll 8
    for (int i = 0; i < 32; ++i) {
        const int d = dp * 32 + i;
        const f32x4 s4 = ((const f32x4*)(S0 + (size_t)d * 256))[vq];
        acc += s4 * qs[d];
        ((f32x4*)(Sn + (size_t)d * 256))[vq] = s4 * gam + vv * ks[d];
    }
    *(LAS f32x4*)(red + dp * 256 + vq * 4) = acc;
    __syncthreads();
    float o = 0.f;
    if (tid < 256) {
        float sm = 0.f;
#pragma unroll
        for (int j = 0; j < 8; ++j) sm += red[j * 256 + tid];
        o = qk * bf2f(zr[ZB_V + h * 256 + tid]) + gam * sm;
        const float s1 = wave_sum(o), s2 = wave_sum(o * o);
        if (lane == 0) { st[wave * 2] = s1; st[wave * 2 + 1] = s2; }
    }
    __syncthreads();
    if (tid < 256) {
        const float s1 = st[0] + st[2] + st[4] + st[6], s2 = st[1] + st[3] + st[5] + st[7];
        const float mean = s1 * (1.f / 256.f), var = fmaxf(s2 * (1.f / 256.f) - mean * mean, 0.f);
        const float yn = (o - mean) / sqrtf(var + 1e-5f) * p.in[I_GBG][h * 256 + tid] + p.in[I_GBB][h * 256 + tid];
        const float g = bf2f(zr[ZB_G + h * 256 + tid]);
        ((bf16*)(p.ws + WS_MIX))[(size_t)row * DM + DA + h * 256 + tid] = (bf16)f2bf(yn * siluf_(g));
    }
    __syncthreads();
}

__device__ __forceinline__ void phase3(const Params& p, LAS unsigned char* lds, const int tid_) {
    const int wave = __builtin_amdgcn_readfirstlane(tid_ >> 6), lane = tid_ & 63;
    const int blk = blockIdx.x;
    __syncthreads();
    if (tid_ < 32) ((LAS unsigned*)(lds + CR_FULL))[tid_] = 0u;
    __syncthreads();
    if (blk < 64) {
        if (wave < 4) chunk_scan(p, blk, wave, lane, lds);
        else chunk_loader(p.ws + WS_CH + (size_t)blk * 128 * CH_BYTES, lds, wave - 4, lane);
        return;
    }
    const int nb = (int)gridDim.x - 64, sw = (blk - 64) + nb * wave, NSW = nb * 8;
    if (nb == 192) {
        const int bq = blk - 64;
        if (wave < 2 || (wave == 2 && bq < 128)) { ret_sample_task(p, wave * 192 + bq, lane); return; }
        const int xcd = blk & 7, li = wave >= 3 ? (wave - 3) * 24 + (bq >> 3) : 120 + ((bq - 128) >> 3);
        const int oi = xcd * 128 + li;
        stepA_task(p, (xcd * 2 + (li >> 6)) * 64 + (li & 63), lane);
        wkv_sample_unit(p, oi, lane); wkv_sample_unit(p, oi + 1024, lane);
        return;
    }
    for (int u = sw; u < MS * 4; u += NSW) ret_sample_task(p, u, lane);
    for (int u = sw; u < MS * 16; u += NSW) wkv_sample_unit(p, u, lane);
    for (int u = sw; u < 1024; u += NSW) stepA_task(p, u, lane);
}

__device__ __forceinline__ void phase4(const Params& p, const int tid_) {
    const int gw = blockIdx.x * 8 + (tid_ >> 6), NGW = gridDim.x * 8, lane = tid_ & 63, hq = lane >> 4, c4 = (lane & 15) * 4;
    const float* YA = (const float*)(p.ws + WS_YA); const bf16* ZB = (const bf16*)(p.ws + WS_ZB); bf16* MIX = (bf16*)(p.ws + WS_MIX);
    const f32x4 rkA[4] = {*(const f32x4*)(p.in[I_RK] + 0 * 256 + lane * 4), *(const f32x4*)(p.in[I_RK] + 1 * 256 + lane * 4), *(const f32x4*)(p.in[I_RK] + 2 * 256 + lane * 4), *(const f32x4*)(p.in[I_RK] + 3 * 256 + lane * 4)};
    constexpr int NU = 4;
    for (int u0 = gw * NU; u0 < MT * 4; u0 += NGW * NU) {
        f32x4 y[NU], r[NU], k2[NU], v[NU]; unsigned long long gwd[NU], vbw[NU];
#pragma unroll
        for (int i = 0; i < NU; ++i) {
            const int u = u0 + i, row = u >> 2, h = (u & 3) * 4 + hq, ch = h * 64 + c4;
            y[i] = *(const f32x4*)(YA + (size_t)row * DA + ch);
            gwd[i] = *(const unsigned long long*)(ZB + (size_t)row * ZBW + ZB_GA + ch);
            if (row < MP) { vbw[i] = *(const unsigned long long*)((const bf16*)(p.ws + WS_OPSA) + (size_t)row * DA + ch); r[i] = k2[i] = v[i] = (f32x4){0.f, 0.f, 0.f, 0.f}; }
            else { const float* base = (const float*)(p.ws + WS_OPSS) + ((size_t)(row - MP) * 16 + h) * 384;
                   r[i] = *(const f32x4*)(base + 256 + c4); k2[i] = *(const f32x4*)(base + 192 + c4); v[i] = *(const f32x4*)(base + 320 + c4); vbw[i] = 0ull; }
        }
        __builtin_amdgcn_sched_barrier(0);
#pragma unroll
        for (int i = 0; i < NU; ++i) {
            const int u = u0 + i, row = u >> 2, h = (u & 3) * 4 + hq, ch = h * 64 + c4;
            const f32x4 rk = rkA[i], gg = *(const f32x4*)(p.in[I_GAG] + ch), gb = *(const f32x4*)(p.in[I_GAB] + ch);
            const float mean = row16_sum((y[i].x + y[i].y) + (y[i].z + y[i].w)) * (1.f / 64.f);
            const f32x4 yc = y[i] - mean;
            const float var = row16_sum((yc.x * yc.x + yc.y * yc.y) + (yc.z * yc.z + yc.w * yc.w)) * (1.f / 64.f);
            const float bsum = row16_sum((r[i].x * k2[i].x * rk.x + r[i].y * k2[i].y * rk.y) + (r[i].z * k2[i].z * rk.z + r[i].w * k2[i].w * rk.w));
            const float rstd = 1.f / sqrtf(var + 64e-5f);
            const f32x4 bon = row < MP ? (f32x4){bflo((unsigned)vbw[i]), bfhi((unsigned)vbw[i]), bflo((unsigned)(vbw[i] >> 32)), bfhi((unsigned)(vbw[i] >> 32))} : v[i] * bsum;
            const f32x4 yn = yc * rstd * gg + gb + bon;
            const f32x4 gt4 = (f32x4){bflo((unsigned)gwd[i]), bfhi((unsigned)gwd[i]), bflo((unsigned)(gwd[i] >> 32)), bfhi((unsigned)(gwd[i] >> 32))};
            *(unsigned long long*)(MIX + (size_t)row * DM + ch) =
                (unsigned long long)pk2(yn.x * siluf_(gt4.x), yn.y * siluf_(gt4.y)) | ((unsigned long long)pk2(yn.z * siluf_(gt4.z), yn.w * siluf_(gt4.w)) << 32);
        }
    }
}

__device__ __forceinline__ void stepC_unit(const Params& p, int unit, LAS unsigned char* lds, const int tid_) {
    const int tid = tid_, wave = tid >> 6, lane = tid & 63, fr = lane & 15, fq = lane >> 4;
    const int bh = unit >> 4, c = unit & 15, b = bh >> 2, h = bh & 3, wr = wave >> 1, wc = wave & 1;
    const int rowb = b * 2048 + c * 128;
    const bf16* ZB = (const bf16*)(p.ws + WS_ZB);
    const bf16* Q = ZB + (size_t)rowb * ZBW + ZB_Q + h * 256;
    const bf16* Kp = ZB + (size_t)rowb * ZBW + ZB_K + h * 256;
    const bf16* VT = (const bf16*)(p.ws + WS_VT) + (size_t)bh * 256 * 2048 + c * 128;
    const bf16* ST = (const bf16*)(p.ws + WS_ST) + ((size_t)(bh * 16 + c) << 16);
    LAS bf16* Pl = (LAS bf16*)lds;
    LAS bf16* Qs = Pl + 128 * 136;
    LAS float* red = (LAS float*)(lds + 110592);
    const float lg = logf(gamma_h(h));
    for (int e = tid; e < 4096; e += 512) {
        const int i = e >> 5, dc = e & 31;
        const u32x4 w = *(const u32x4*)(Q + (size_t)i * ZBW + dc * 8);
        const float sc = expf((float)(i + 1) * lg);
        u32x4 o; o.x = pk2(bflo(w.x) * sc, bfhi(w.x) * sc); o.y = pk2(bflo(w.y) * sc, bfhi(w.y) * sc); o.z = pk2(bflo(w.z) * sc, bfhi(w.z) * sc); o.w = pk2(bflo(w.w) * sc, bfhi(w.w) * sc);
        *(LAS u32x4*)(Qs + i * 264 + dc * 8) = o;
    }
    {
        f32x4 sa[2][4];
#pragma unroll
        for (int m = 0; m < 2; ++m)
#pragma unroll
            for (int n = 0; n < 4; ++n) sa[m][n] = (f32x4){0.f, 0.f, 0.f, 0.f};
#pragma unroll 1
        for (int ks = 0; ks < 8; ++ks) {
            bf16x8 A[2];
            const bf16* qa = Q + (size_t)(wr * 32 + fr) * ZBW + ks * 32 + fq * 8; const bf16* kb = Kp + (size_t)(wc * 64 + fr) * ZBW + ks * 32 + fq * 8;
            asm volatile("" : "+v"(qa), "+v"(kb));
#pragma unroll
            for (int m = 0; m < 2; ++m) A[m] = *(const bf16x8*)(qa + (size_t)(m * 16) * ZBW);
            bf16x8 B[4];
#pragma unroll
            for (int n = 0; n < 4; ++n) B[n] = *(const bf16x8*)(kb + (size_t)(n * 16) * ZBW);
            __builtin_amdgcn_sched_barrier(0);
#pragma unroll
            for (int n = 0; n < 4; ++n)
#pragma unroll
                for (int m = 0; m < 2; ++m) sa[m][n] = __builtin_amdgcn_mfma_f32_16x16x32_bf16(B[n], A[m], sa[m][n], 0, 0, 0);
        }
#pragma unroll
        for (int m = 0; m < 2; ++m)
#pragma unroll
            for (int n = 0; n < 4; ++n)
            {
                const int i = wr * 32 + m * 16 + fr, j0 = wc * 64 + n * 16 + fq * 4;
                float pv[4];
#pragma unroll
                for (int r = 0; r < 4; ++r) pv[r] = i >= j0 + r ? sa[m][n][r] * __expf((float)(i - j0 - r) * lg) : 0.f;
                *(LAS unsigned long long*)(Pl + i * 136 + j0) = (unsigned long long)pk2(pv[0], pv[1]) | ((unsigned long long)pk2(pv[2], pv[3]) << 32);
            }
    }
    __syncthreads();
    f32x4 oa[2][8];
#pragma unroll
    for (int m = 0; m < 2; ++m)
#pragma unroll
        for (int n = 0; n < 8; ++n) oa[m][n] = (f32x4){0.f, 0.f, 0.f, 0.f};
#pragma unroll 1
    for (int ks = 0; ks < 4; ++ks) {
        bf16x8 A[2];
        const bf16* vb = VT + (size_t)(wc * 128 + fr) * 2048 + ks * 32 + fq * 8;
        asm volatile("" : "+v"(vb));
#pragma unroll
        for (int m = 0; m < 2; ++m) A[m] = *(LAS const bf16x8*)(Pl + (wr * 32 + m * 16 + fr) * 136 + ks * 32 + fq * 8);
        bf16x8 B[8];
#pragma unroll
        for (int n = 0; n < 8; ++n) B[n] = *(const bf16x8*)(vb + (size_t)(n * 16) * 2048);
        __builtin_amdgcn_sched_barrier(0);
#pragma unroll
        for (int n = 0; n < 8; ++n)
#pragma unroll
            for (int m = 0; m < 2; ++m) oa[m][n] = __builtin_amdgcn_mfma_f32_16x16x32_bf16(B[n], A[m], oa[m][n], 0, 0, 0);
    }
    if (c > 0) {
#pragma unroll 1
        for (int ks = 0; ks < 8; ++ks) {
            bf16x8 A[2];
            const bf16* sb = ST + (size_t)(wc * 128 + fr) * 256 + ks * 32 + fq * 8;
            asm volatile("" : "+v"(sb));
#pragma unroll
            for (int m = 0; m < 2; ++m) A[m] = *(LAS const bf16x8*)(Qs + (wr * 32 + m * 16 + fr) * 264 + ks * 32 + fq * 8);
            bf16x8 B[8];
#pragma unroll
            for (int n = 0; n < 8; ++n) B[n] = *(const bf16x8*)(sb + (size_t)(n * 16) * 256);
            __builtin_amdgcn_sched_barrier(0);
#pragma unroll
            for (int n = 0; n < 8; ++n)
#pragma unroll
                for (int m = 0; m < 2; ++m) oa[m][n] = __builtin_amdgcn_mfma_f32_16x16x32_bf16(B[n], A[m], oa[m][n], 0, 0, 0);
        }
    }
#pragma unroll
    for (int m = 0; m < 2; ++m) {
        float s1 = 0.f, s2 = 0.f;
#pragma unroll
        for (int n = 0; n < 8; ++n) { const f32x4 v = oa[m][n]; s1 += (v.x + v.y) + (v.z + v.w); s2 += (v.x * v.x + v.y * v.y) + (v.z * v.z + v.w * v.w); }
        s1 += __shfl_xor(s1, 16); s1 += __shfl_xor(s1, 32); s2 += __shfl_xor(s2, 16); s2 += __shfl_xor(s2, 32);
        if (fq == 0) { const int i = wr * 32 + m * 16 + fr; red[(i * 2 + wc) * 2] = s1; red[(i * 2 + wc) * 2 + 1] = s2; }
    }
    __syncthreads();
    bf16* MIX = (bf16*)(p.ws + WS_MIX);
#pragma unroll
    for (int m = 0; m < 2; ++m) {
        const int i = wr * 32 + m * 16 + fr;
        const float s1 = red[i * 4] + red[i * 4 + 2], s2 = red[i * 4 + 1] + red[i * 4 + 3];
        const float mean = s1 * (1.f / 256.f), var = fmaxf(s2 * (1.f / 256.f) - mean * mean, 0.f), rstd = 1.f / sqrtf(var + 1e-5f);
#pragma unroll
        for (int n = 0; n < 8; ++n) {
            const int v0 = wc * 128 + n * 16 + 4 * fq;
            const f32x4 gg = *(const f32x4*)(p.in[I_GBG] + h * 256 + v0), gb = *(const f32x4*)(p.in[I_GBB] + h * 256 + v0);
            const unsigned long long gw = *(const unsigned long long*)(ZB + (size_t)(rowb + i) * ZBW + ZB_G + h * 256 + v0);
            const f32x4 g4 = (f32x4){bflo((unsigned)gw), bfhi((unsigned)gw), bflo((unsigned)(gw >> 32)), bfhi((unsigned)(gw >> 32))};
            const f32x4 yn = (oa[m][n] - mean) * rstd * gg + gb;
            *(unsigned long long*)(MIX + (size_t)(rowb + i) * DM + DA + h * 256 + v0) =
                (unsigned long long)pk2(yn.x * siluf_(g4.x), yn.y * siluf_(g4.y)) | ((unsigned long long)pk2(yn.z * siluf_(g4.z), yn.w * siluf_(g4.w)) << 32);
        }
    }
    __syncthreads();
}

__device__ __forceinline__ void phase8(const Params& p, const int tid_) {
    const int gw = blockIdx.x * 8 + (tid_ >> 6), NGW = gridDim.x * 8, lane = tid_ & 63;
    const float* rss = (const float*)(p.ws + WS_RSS); const float* g = p.in[I_GFIN];
    for (int row = gw; row < MT; row += NGW) {
        const float rstd = 1.f / sqrtf(rss[row] * (1.f / DM) + 1e-6f);
        f32x4* o = (f32x4*)(p.out + (size_t)row * DM); const bf16* h3 = (const bf16*)(p.ws + WS_H2) + (size_t)row * DM;
#pragma unroll
        for (int j = 0; j < 8; ++j) { const f32x4 gg = ((const f32x4*)g)[lane + 64 * j]; o[lane + 64 * j] = ldz4(h3 + (lane + 64 * j) * 4) * rstd * gg; }
    }
}

__device__ __forceinline__ void skinny_block(const bf16* A, const bf16* Bt, int r0, int c0, LAS unsigned char* lds, const int tid_, float (&res)[2]) {
    const int wave = tid_ >> 6, lane = tid_ & 63, fr = lane & 15, fq = lane >> 4;
    const bf16* a = A + (size_t)(r0 + fr) * DM + wave * 256 + fq * 8; const bf16* bp = Bt + (size_t)(c0 + fr) * DM + wave * 256 + fq * 8;
    bf16x8 bv[8], av[4][8];
#pragma unroll
    for (int ks = 0; ks < 8; ++ks) bv[ks] = *(const bf16x8*)(bp + ks * 32);
#pragma unroll
    for (int m = 0; m < 4; ++m)
#pragma unroll
        for (int ks = 0; ks < 8; ++ks) av[m][ks] = *(const bf16x8*)(a + (size_t)(m * 16) * DM + ks * 32);
    __builtin_amdgcn_sched_barrier(0);
    LAS float* red = (LAS float*)lds;
#pragma unroll
    for (int m = 0; m < 4; ++m) {
        f32x4 acc = (f32x4){0.f, 0.f, 0.f, 0.f};
#pragma unroll
        for (int ks = 0; ks < 8; ++ks) acc = __builtin_amdgcn_mfma_f32_16x16x32_bf16(av[m][ks], bv[ks], acc, 0, 0, 0);
#pragma unroll
        for (int r = 0; r < 4; ++r) red[((wave * 4 + m) * 16 + 4 * fq + r) * 16 + fr] = acc[r];
    }
    __syncthreads();
#pragma unroll
    for (int j = 0; j < 2; ++j) {
        const int o = tid_ + j * 512;
        float s = 0.f;
#pragma unroll
        for (int w = 0; w < 8; ++w) s += red[w * 1024 + o];
        res[j] = s;
    }
    __syncthreads();
}
__device__ __forceinline__ void skinny_gemm2(const Params& p, LAS unsigned char* lds, const int tid_) {
    const int r0 = MP + (blockIdx.x & 1) * 64, c0 = (blockIdx.x >> 1) * 16;
    if (blockIdx.x >= 256) return;
    float res[2];
    skinny_block((const bf16*)(p.ws + WS_MIX), (const bf16*)(p.ws + WS_WOUTT), r0, c0, lds, tid_, res);
#pragma unroll
    for (int j = 0; j < 2; ++j) {
        const int o = tid_ + j * 512, row = r0 + (o >> 4), col = c0 + (o & 15);
        const float v = res[j] + p.in[I_XS][(size_t)(row - MP) * DM + col];
        ((bf16*)(p.ws + WS_H2B))[(size_t)row * DM + col] = (bf16)f2bf(v);
    }
}
__device__ __forceinline__ void skinny_gemm3(const Params& p, LAS unsigned char* lds, const int tid_) {
    const int r0 = MP + (blockIdx.x & 1) * 64, c0 = (blockIdx.x >> 1) * 16;
    if (blockIdx.x >= 256) return;
    float res[2];
    skinny_block((const bf16*)(p.ws + WS_H2B), (const bf16*)(p.ws + WS_WGT), r0, c0, lds, tid_, res);
#pragma unroll
    for (int j = 0; j < 2; ++j) {
        const int o = tid_ + j * 512, row = r0 + (o >> 4), col = c0 + (o & 15);
        const float h2 = bf2f(((const bf16*)(p.ws + WS_H2B))[(size_t)row * DM + col]), pl = bf2f(((const bf16*)(p.ws + WS_PLE))[(size_t)row * DM + col]);
        const float ov = h2 + sigmoidf_(res[j]) * pl;
        ((bf16*)(p.ws + WS_H2))[(size_t)row * DM + col] = (bf16)f2bf(ov);
        const float ss = row16_sum(ov * ov);
        if ((tid_ & 15) == 0) atomicAdd((float*)(p.ws + WS_RSS) + row, ss);
    }
}
#ifndef REP1
#define REP1 1
#endif
#ifndef REP5
#define REP5 1
#endif
#ifndef REP6
#define REP6 1
#endif
#ifndef REP0
#define REP0 1
#endif
#ifndef REP2
#define REP2 1
#endif
#ifndef REP3
#define REP3 1
#endif
#ifndef REP4
#define REP4 1
#endif
#define XB_TMO      128
#define XB_XCNT(j)  (256  + 64 * (j))
#define XB_XSUB(j)  (1280 + 64 * (j))
#define XB_XGEN(j)  (2304 + 64 * (j))
#define XB_TOP      3328
#define XB_TOPGEN   3392
#define XCD_BAR_WORDS 3456
#define XB_SPIN_CAP (1u << 18)

__device__ __forceinline__ unsigned xb_ld(unsigned* p)              { return __hip_atomic_load(p, __ATOMIC_RELAXED, __HIP_MEMORY_SCOPE_AGENT); }
__device__ __forceinline__ unsigned xb_add(unsigned* p, unsigned v) { return __hip_atomic_fetch_add(p, v, __ATOMIC_RELAXED, __HIP_MEMORY_SCOPE_AGENT); }
__device__ __forceinline__ unsigned xb_xcc_id() { return (unsigned)__builtin_amdgcn_s_getreg((3 << 11) | 20) & 0xFu; }
#define XB_SPIN(cond, bar) do { unsigned _sp = 0; while (cond) { __builtin_amdgcn_s_sleep(1); \
    if ((++_sp & 255u) == 0u) { if (xb_ld(&(bar)[XB_TMO])) break; if (_sp > XB_SPIN_CAP) { atomicAdd(&(bar)[XB_TMO], 1u); break; } } } } while (0)

struct XcdBarrier {
    unsigned* bar; unsigned x;
    volatile LAS unsigned* st;
};

__device__ __forceinline__ XcdBarrier xcd_barrier_post(unsigned* bar, volatile LAS unsigned* st, const int tid_) {
    XcdBarrier b; b.bar = bar; b.x = xb_xcc_id(); b.st = st;
    if (tid_ == 0) (void)xb_add(&bar[XB_XCNT(b.x)], 1u);
    return b;
}
__device__ __forceinline__ void xcd_barrier_complete(unsigned* bar, unsigned x, unsigned& nloc, unsigned& nx) {
    const unsigned G = gridDim.x * gridDim.y * gridDim.z;
    unsigned sum, cnt, mine, sp = 0u;
    for (;;) {
        sum = 0u; cnt = 0u; mine = 0u;
#pragma unroll
        for (unsigned j = 0; j < 16; ++j) { const unsigned c = xb_ld(&bar[XB_XCNT(j)]); sum += c; cnt += (c > 0u) ? 1u : 0u; mine = (j == x) ? c : mine; }
        if (sum == G) break;
        __builtin_amdgcn_s_sleep(1);
        if ((++sp & 255u) == 0u) { if (xb_ld(&bar[XB_TMO])) break; if (sp > XB_SPIN_CAP) { atomicAdd(&bar[XB_TMO], 1u); break; } }
    }
    nloc = mine > 0u ? mine : 1u; nx = cnt > 0u ? cnt : 1u;
}

__device__ __forceinline__ void xcd_barrier(const XcdBarrier& b, const int tid_) {
    asm volatile("s_waitcnt vmcnt(0)" ::: "memory");
    __syncthreads();
    if (tid_ == 0) {
        unsigned* bar = b.bar;
        __builtin_amdgcn_s_waitcnt(0);
        unsigned nloc = b.st[0], nx = b.st[1];
        if (nloc == 0u) { xcd_barrier_complete(bar, b.x, nloc, nx); b.st[0] = nloc; b.st[1] = nx; }
        const unsigned old = xb_add(&bar[XB_XSUB(b.x)], 1u);
        const unsigned gen = old / nloc;
        if (old + 1u == (gen + 1u) * nloc) {
            __builtin_amdgcn_fence(__ATOMIC_RELEASE, "agent");
            asm volatile("s_waitcnt vmcnt(0)" ::: "memory");
            const unsigned og = xb_add(&bar[XB_TOP], 1u);
            const unsigned tg = og / nx;
            if (og + 1u == (tg + 1u) * nx) xb_add(&bar[XB_TOPGEN], 1u);
            else XB_SPIN(xb_ld(&bar[XB_TOPGEN]) == tg, bar);
            __builtin_amdgcn_fence(__ATOMIC_ACQUIRE, "agent");
            xb_add(&bar[XB_XGEN(b.x)], 1u);
            asm volatile("s_waitcnt vmcnt(0)" ::: "memory");
        } else {
            XB_SPIN(xb_ld(&bar[XB_XGEN(b.x)]) == gen, bar);
            __builtin_amdgcn_fence(__ATOMIC_ACQUIRE, "agent");
            asm volatile("s_waitcnt vmcnt(0)" ::: "memory");
        }
    }
    __syncthreads();
}

__global__ void __launch_bounds__(512, 2) mega(Params p_) {
    extern __shared__ __attribute__((aligned(16))) unsigned char lds_raw[];
    LAS unsigned char* lds = (LAS unsigned char*)lds_raw;
    const int lo = p_.ph_lo, hi = p_.ph_hi;
#ifdef ONLY_PHASE
#define IN(k) ((k) == ONLY_PHASE && lo <= (k) && (k) < hi)
#else
#define IN(k) (lo <= (k) && (k) < hi)
#endif
#define SEAM(k) do { if (IN(k) && IN((k) + 1)) { const int tid_ = my_tid(wv); XcdBarrier bb; bb.bar = (unsigned*)(kparams().ws + WS_CTL); bb.x = xb_xcc_id(); bb.st = (volatile LAS unsigned*)(lds + 133120); xcd_barrier(bb, tid_); } } while (0)
    volatile LAS unsigned* bst = (volatile LAS unsigned*)(lds + 133120);
    const int tid0 = threadIdx.x; const int wv = __builtin_amdgcn_readfirstlane(tid0 >> 6);
    if (tid0 < 16) bst[tid0] = 0u;
    __syncthreads();
    if (hi - lo > 1) (void)xcd_barrier_post((unsigned*)(kparams().ws + WS_CTL), bst, tid0);
    if (hi == 12345) cg::this_grid().sync();
    if (IN(0)) { const Params& p = kparams(); unsigned char* ws = p.ws; (void)ws; const int tid_ = my_tid(wv); for (int rep = 0; rep < REP0; ++rep) phase0(p, lds, tid_); } SEAM(0);
    if (IN(1)) { const Params& p = kparams(); unsigned char* ws = p.ws; (void)ws; const int tid_ = my_tid(wv);
        pg8::Gemm g{(const bf16*)(ws + WS_XN), (const bf16*)(ws + WS_WINT), MPAD, NCPAD, DM}; pg8::StaticOrder S; S.init(MPAD, NCPAD, gridDim.x, blockIdx.x);
        Epi1 E{(bf16*)(ws + WS_ZA), (bf16*)(ws + WS_ZB), (const float2*)(ws + WS_ROT)};
        for (int rep = 0; rep < REP1; ++rep) pg8::gemm_phase<Epi1, pg8::StaticOrder, true, true>(lds, g, S, E, tid_);
    } SEAM(1);
    if (IN(2)) { const Params& p = kparams(); unsigned char* ws = p.ws; (void)ws; const int tid_ = my_tid(wv); for (int rep = 0; rep < REP2; ++rep) phase2(p, lds, tid_); } SEAM(2);
    if (IN(3)) { const Params& p = kparams(); unsigned char* ws = p.ws; (void)ws; const int tid_ = my_tid(wv); for (int rep = 0; rep < REP3; ++rep) phase3(p, lds, tid_); } SEAM(3);
    if (IN(4)) { const Params& p = kparams(); unsigned char* ws = p.ws; (void)ws; const int tid_ = my_tid(wv); for (int rep = 0; rep < REP4; ++rep) phase4(p, tid_); }
    if (IN(5)) { const Params& p = kparams(); unsigned char* ws = p.ws; (void)ws; const int tid_ = my_tid(wv);
#ifndef SKC
        for (int rep = 0; rep < REP5; ++rep) for (int u = blockIdx.x; u < 256; u += gridDim.x) stepC_unit(p, u, lds, tid_);
#endif
        { pg8::Gemm g{(const bf16*)(ws + WS_PB), (const bf16*)(ws + WS_WPLET), MPAD, DM, 256}; pg8::StaticOrder S; S.init(MPAD, DM, gridDim.x, blockIdx.x);
          EpiPle E{(bf16*)(ws + WS_PLE)};
#ifndef SKPLE
          pg8::gemm_phase<EpiPle, pg8::StaticOrder, true, true>(lds, g, S, E, tid_);
#endif
        }
    } SEAM(5);
    if (IN(6)) { const Params& p = kparams(); unsigned char* ws = p.ws; (void)ws; const int tid_ = my_tid(wv);
        skinny_gemm2(p, lds, tid_);
        { pg8::Gemm g{(const bf16*)(ws + WS_MIX), (const bf16*)(ws + WS_WOUTT), MP, DM, DM}; pg8::StaticOrder S; S.init(MP, DM, gridDim.x, blockIdx.x);
          Epi2 E{p.in[I_XP], p.in[I_XS], (float*)(ws + WS_H2), (bf16*)(ws + WS_H2B)};
          for (int rep = 0; rep < REP6; ++rep) pg8::gemm_phase<Epi2, pg8::StaticOrder, true, true>(lds, g, S, E, tid_); }
    } SEAM(6);
    if (IN(7)) { const Params& p = kparams(); unsigned char* ws = p.ws; (void)ws; const int tid_ = my_tid(wv);
        skinny_gemm3(p, lds, tid_);
        pg8::Gemm g{(const bf16*)(ws + WS_H2B), (const bf16*)(ws + WS_WGT), MP, DM, DM}; pg8::StaticOrder S; S.init(MP, DM, gridDim.x, blockIdx.x);
        Epi3 E{(const bf16*)(ws + WS_H2B), (const bf16*)(ws + WS_PLE), (bf16*)(ws + WS_H2), (float*)(ws + WS_RSS)};
        pg8::gemm_phase<Epi3, pg8::StaticOrder, true, true>(lds, g, S, E, tid_);
    } SEAM(7);
    if (IN(8)) { const Params& p = kparams(); unsigned char* ws = p.ws; (void)ws; const int tid_ = my_tid(wv); phase8(p, tid_); }
#undef IN
#undef SEAM
}

#ifndef N_LAUNCH_PER_PHASE
#define N_LAUNCH_PER_PHASE 0
#endif
extern "C" void kernel_launch(void* const* d_in, const int* in_sizes, int n_in, void* d_out, int out_size, void* d_ws, size_t ws_size, hipStream_t stream) {
    static int grid = 0;
    if (grid == 0) {
        if (n_in != 25 || ws_size < WS_END) { fprintf(stderr, "kernel_launch: unexpected inputs (n_in %d, ws %zu < %zu)\n", n_in, ws_size, (size_t)WS_END); grid = -1; return; }
        int dev = 0, cus = 0, per_cu = 0;
        hipGetDevice(&dev); hipDeviceGetAttribute(&cus, hipDeviceAttributeMultiprocessorCount, dev);
        if (hipFuncSetAttribute((const void*)mega, hipFuncAttributeMaxDynamicSharedMemorySize, LDS_BYTES) != hipSuccess) { fprintf(stderr, "hipFuncSetAttribute failed\n"); grid = -1; return; }
        hipOccupancyMaxActiveBlocksPerMultiprocessor(&per_cu, (const void*)mega, 512, LDS_BYTES);
        if (per_cu < 1) per_cu = 1;
        grid = cus * per_cu;
        (void)hipGetLastError();
    }
    if (grid < 0) return;
    Params p{};
    for (int i = 0; i < 25; ++i) p.in[i] = (const float*)d_in[i];
    p.out = (float*)d_out; p.ws = (unsigned char*)d_ws;
#if N_LAUNCH_PER_PHASE
    for (int ph = 0; ph < 9; ++ph) { p.ph_lo = ph; p.ph_hi = ph + 1; hipLaunchKernelGGL(mega, dim3(grid), dim3(512), LDS_BYTES, stream, p); }
#else
    p.ph_lo = 0; p.ph_hi = 9;
    (void)hipMemsetAsync(d_ws, 0, 16384, stream);
    void* args[] = {&p};
    hipError_t e = hipLaunchCooperativeKernel((const void*)mega, dim3(grid), dim3(512), args, LDS_BYTES, stream);
    if (e != hipSuccess) fprintf(stderr, "cooperative launch failed: %s (grid %d)\n", hipGetErrorString(e), grid);
#endif
}
```

```cpp
#include <hip/hip_runtime.h>
#include <hip/hip_cooperative_groups.h>
#include <cstdio>
#include <cstdint>
namespace cg = cooperative_groups;
namespace pg8 {
#define PG8_LAS __attribute__((address_space(3)))
typedef unsigned short bf16_t;
typedef short bf16x8 __attribute__((ext_vector_type(8)));
typedef float f32x4 __attribute__((ext_vector_type(4)));
typedef unsigned u32x4 __attribute__((ext_vector_type(4)));
constexpr int BM = 256, BK = 64, HALF = 128, HTB = HALF * BK * 2  , STAGE_BYTES = 8 * HTB, NXCD = 8, WGM = 8;

__host__ __device__ __forceinline__ int lds_byte(int r, int c) { const int st = (r >> 4) * 2 + (c >> 5), rr = r & 15, cc = c & 31, ob = rr * 64 + cc * 2; return st * 1024 + (ob ^ (((ob >> 9) & 1) << 5)); }
__host__ __device__ __forceinline__ void stage_rc(int b, int& R, int& C) { const int st = b / 1024, sb = b % 1024, swz = sb ^ (((sb >> 9) & 1) << 5); R = (st >> 1) * 16 + swz / 64; C = (st & 1) * 32 + (swz % 64) / 2; }
__host__ __device__ __forceinline__ int perm32(int rho) { const int n = rho >> 4, i = rho & 15; return 8 * (i >> 2) + 4 * n + (i & 3); }

struct Unit { int pm, pn; };
struct Gemm { const bf16_t* A; const bf16_t* Bt; int M, N, K; };

struct StaticOrder {
    int nM, nN, nwg, G, c;
    __host__ __device__ void init(int M, int N, int G_, int c_) { nM = M / BM; nN = N / BM; nwg = nM * nN; G = G_; c = c_; }
    __host__ __device__ bool next(int i, Unit& u) const {
        const long L = (long)i * G + c; if (L >= nwg) return false;
        int wgid = (int)L; { const int q = nwg / NXCD, r = nwg % NXCD, xcd = wgid % NXCD, off = wgid / NXCD; wgid = (xcd < r ? xcd * (q + 1) : r * (q + 1) + (xcd - r) * q) + off; }
        const int nig = WGM * nN, gid = wgid / nig, fm = gid * WGM, gsz = (nM - fm) < WGM ? (nM - fm) : WGM;
        u.pm = fm + ((wgid % nig) % gsz); u.pn = (wgid % nig) / gsz; return true;
    }
    __device__ __forceinline__ void a_ready(const Unit&) const {}
    __device__ __forceinline__ void done(const Unit&) const {}
};
__device__ __forceinline__ unsigned cvt_pk_bf16(float lo, float hi) { unsigned r; asm volatile("v_cvt_pk_bf16_f32 %0, %1, %2" : "=v"(r) : "v"(lo), "v"(hi)); return r; }
typedef float f32x2 __attribute__((ext_vector_type(2)));
template <class Epi, class Sched, bool ALIGN_EPI = false, bool SP2 = false>
__device__ __forceinline__ void gemm_phase(PG8_LAS unsigned char* lds, const Gemm g, const Sched& S, const Epi& E, const int tid_) {
    const int tid = tid_, wid = __builtin_amdgcn_readfirstlane(tid >> 6), lane = tid & 63, wr = wid >> 2, wc = wid & 3, fr = lane & 15, fq = lane >> 4;
    const int K = g.K, nt = K / BK;
    unsigned voffA[2], voffB[2];
#pragma unroll
    for (int i = 0; i < 2; ++i) { int R, C; stage_rc(tid * 16 + i * 8192, R, C); const int Rb = Epi::PERM ? ((R & ~31) + perm32(R & 31)) : R;
        voffA[i] = (unsigned)(R * K + C) * 2u; voffB[i] = (unsigned)(Rb * K + C) * 2u; }
    const size_t kstep = (size_t)(BK * 2);
    const size_t hstep = (size_t)HALF * K * 2;
    const size_t tstep = 2 * hstep;
    const unsigned ldsw = (unsigned)wid * 1024u;
    const int aoff = lds_byte(wr * 64 + fr, fq * 8), boff = lds_byte(wc * 32 + fr, fq * 8);
#define PG8_SA(b, h) (((b) * 2 + (h)) * HTB)
#define PG8_SB(b, h) ((4 + (b) * 2 + (h)) * HTB)
#define PG8_STAGE(bufoff, gbase, voff) do { _Pragma("unroll") for (int _i = 0; _i < 2; ++_i) \
        __builtin_amdgcn_global_load_lds((const unsigned*)((const char*)(gbase) + (voff)[_i]), (PG8_LAS unsigned*)(lds + (bufoff) + ldsw + _i * 8192), 16, 0, 0); } while (0)
#define PG8_LDA(dst, b, h) do { _Pragma("unroll") for (int m = 0; m < 4; ++m) _Pragma("unroll") for (int k = 0; k < 2; ++k) dst[m][k] = *(const PG8_LAS bf16x8*)(lds + PG8_SA(b, h) + aoff + m * 2048 + k * 1024); } while (0)
#define PG8_LDB(dst, b, h) do { _Pragma("unroll") for (int n = 0; n < 2; ++n) _Pragma("unroll") for (int k = 0; k < 2; ++k) dst[n][k] = *(const PG8_LAS bf16x8*)(lds + PG8_SB(b, h) + boff + n * 2048 + k * 1024); } while (0)
#define PG8_MMA(ai, bj, At, Bt) do { __builtin_amdgcn_s_setprio(1); _Pragma("unroll") for (int m = 0; m < 4; ++m) _Pragma("unroll") for (int n = 0; n < 2; ++n) _Pragma("unroll") for (int k = 0; k < 2; ++k) \
        acc[ai][bj][m][n] = __builtin_amdgcn_mfma_f32_16x16x32_bf16(Bt[n][k], At[m][k], acc[ai][bj][m][n], 0, 0, 0); __builtin_amdgcn_s_setprio(0); } while (0)
#define PG8_WAIT_V(n) asm volatile("s_waitcnt vmcnt(" #n ")" ::: "memory")
#define PG8_WAIT_L(n) asm volatile("s_waitcnt lgkmcnt(" #n ")" ::: "memory")
#define PG8_BAR __builtin_amdgcn_s_barrier()
#define PG8_SCHED __builtin_amdgcn_sched_barrier(0)
    Unit cur, nxt; int ui = 0;
    if (!S.next(0, cur)) return;
    f32x4 acc[2][2][4][2];
#pragma unroll
    for (int a = 0; a < 2; ++a)
#pragma unroll
        for (int b = 0; b < 2; ++b)
#pragma unroll
            for (int m = 0; m < 4; ++m)
#pragma unroll
                for (int n = 0; n < 2; ++n) acc[a][b][m][n] = (f32x4){0.f, 0.f, 0.f, 0.f};
    bf16x8 At[4][2], B0[2][2], B1[2][2];
    const char* cA = (const char*)g.A + (size_t)cur.pm * tstep; const char* cB = (const char*)g.Bt + (size_t)cur.pn * tstep;
    S.a_ready(cur);
    if constexpr (SP2) {
        PG8_STAGE(PG8_SB(0, 0), cB, voffB); PG8_STAGE(PG8_SB(0, 1), cB + hstep, voffB); PG8_STAGE(PG8_SA(0, 0), cA, voffA); PG8_STAGE(PG8_SA(0, 1), cA + hstep, voffA);
        if (wr == 1) PG8_BAR;
        PG8_WAIT_V(2); PG8_BAR;
        PG8_STAGE(PG8_SB(1, 0), cB + kstep, voffB); PG8_STAGE(PG8_SA(1, 0), cA + kstep, voffA); PG8_STAGE(PG8_SB(1, 1), cB + hstep + kstep, voffB);
        PG8_WAIT_V(6); PG8_BAR;
    } else {
        PG8_STAGE(PG8_SB(0, 0), cB, voffB); PG8_STAGE(PG8_SA(0, 0), cA, voffA); PG8_STAGE(PG8_SB(0, 1), cB + hstep, voffB); PG8_STAGE(PG8_SA(0, 1), cA + hstep, voffA);
        if (wr == 1) PG8_BAR;
        PG8_WAIT_V(4); PG8_BAR;
        PG8_STAGE(PG8_SB(1, 0), cB + kstep, voffB); PG8_STAGE(PG8_SA(1, 0), cA + kstep, voffA); PG8_STAGE(PG8_SB(1, 1), cB + hstep + kstep, voffB);
        PG8_WAIT_V(6); PG8_BAR;
    }
    for (;;) {
        const bool has_next = S.next(ui + 1, nxt);
        const char* nA = has_next ? (const char*)g.A + (size_t)nxt.pm * tstep : cA; const char* nB = has_next ? (const char*)g.Bt + (size_t)nxt.pn * tstep : cB;
        for (int t = 0; t < nt; t += 2) {
            const bool last = (t == nt - 2);
            const char* a1 = cA + (size_t)(t + 1) * kstep;
            const char* a2 = last ? nA : cA + (size_t)(t + 2) * kstep; const char* b2 = last ? nB : cB + (size_t)(t + 2) * kstep;
            const char* a3 = a2 + kstep; const char* b3 = b2 + kstep;
            if (last && has_next) S.a_ready(nxt);
            if constexpr (SP2) {
            PG8_LDB(B0, 0, 0); PG8_LDB(B1, 0, 1); PG8_SCHED; PG8_LDA(At, 0, 0); PG8_STAGE(PG8_SA(1, 1), a1 + hstep, voffA);
            PG8_WAIT_V(8); PG8_WAIT_L(0); PG8_BAR; PG8_MMA(0, 0, At, B0); PG8_MMA(0, 1, At, B1); PG8_BAR; PG8_SCHED;
            PG8_LDA(At, 0, 1); PG8_STAGE(PG8_SB(0, 0), b2, voffB); PG8_STAGE(PG8_SB(0, 1), b2 + hstep, voffB); PG8_STAGE(PG8_SA(0, 0), a2, voffA);
            PG8_WAIT_V(8); PG8_WAIT_L(0); PG8_BAR; PG8_MMA(1, 0, At, B0); PG8_MMA(1, 1, At, B1); PG8_BAR; PG8_SCHED;
            PG8_LDB(B0, 1, 0); PG8_LDB(B1, 1, 1); PG8_SCHED; PG8_LDA(At, 1, 0); PG8_STAGE(PG8_SA(0, 1), a2 + hstep, voffA);
            PG8_WAIT_V(8); PG8_WAIT_L(0); PG8_BAR; PG8_MMA(0, 0, At, B0); PG8_MMA(0, 1, At, B1); PG8_BAR; PG8_SCHED;
            PG8_LDA(At, 1, 1); PG8_STAGE(PG8_SB(1, 0), b3, voffB); PG8_STAGE(PG8_SB(1, 1), b3 + hstep, voffB); PG8_STAGE(PG8_SA(1, 0), a3, voffA);
            PG8_WAIT_V(8); PG8_WAIT_L(0); PG8_BAR; PG8_MMA(1, 0, At, B0); PG8_MMA(1, 1, At, B1); PG8_BAR; PG8_SCHED;
            } else {
            PG8_LDB(B0, 0, 0); PG8_SCHED; PG8_LDA(At, 0, 0); PG8_STAGE(PG8_SA(1, 1), a1 + hstep, voffA);
            PG8_WAIT_L(8); PG8_BAR; PG8_WAIT_L(0); PG8_MMA(0, 0, At, B0); PG8_BAR; PG8_SCHED;
            PG8_LDB(B1, 0, 1); PG8_STAGE(PG8_SB(0, 0), b2, voffB);
            PG8_BAR; PG8_WAIT_L(0); PG8_MMA(0, 1, At, B1); PG8_BAR;
            PG8_LDA(At, 0, 1); PG8_STAGE(PG8_SA(0, 0), a2, voffA);
            PG8_BAR; PG8_WAIT_L(0); PG8_MMA(1, 0, At, B0); PG8_BAR; PG8_SCHED;
            PG8_STAGE(PG8_SB(0, 1), b2 + hstep, voffB);
            PG8_WAIT_V(6); PG8_BAR; PG8_MMA(1, 1, At, B1); PG8_BAR;
            PG8_LDB(B0, 1, 0); PG8_SCHED; PG8_LDA(At, 1, 0); PG8_STAGE(PG8_SA(0, 1), a2 + hstep, voffA);
            PG8_WAIT_L(8); PG8_BAR; PG8_WAIT_L(0); PG8_MMA(0, 0, At, B0); PG8_BAR; PG8_SCHED;
            PG8_LDB(B1, 1, 1); PG8_STAGE(PG8_SB(1, 0), b3, voffB);
            PG8_BAR; PG8_WAIT_L(0); PG8_MMA(0, 1, At, B1); PG8_BAR;
            PG8_LDA(At, 1, 1); PG8_STAGE(PG8_SA(1, 0), a3, voffA);
            PG8_BAR; PG8_WAIT_L(0); PG8_MMA(1, 0, At, B0); PG8_BAR; PG8_SCHED;
            PG8_STAGE(PG8_SB(1, 1), b3 + hstep, voffB);
            PG8_WAIT_V(6); PG8_BAR; PG8_MMA(1, 1, At, B1); PG8_BAR;
            }
        }
        if constexpr (ALIGN_EPI) { if (wr == 0) PG8_BAR; }
        if constexpr (!Epi::AFTER_DRAIN) { E(acc, cur, wr, wc, fr, fq); S.done(cur); }
        if (!has_next) break;
#pragma unroll
        for (int a = 0; a < 2; ++a)
#pragma unroll
            for (int b = 0; b < 2; ++b)
#pragma unroll
                for (int m = 0; m < 4; ++m)
#pragma unroll
                    for (int n = 0; n < 2; ++n) acc[a][b][m][n] = (f32x4){0.f, 0.f, 0.f, 0.f};
        cur = nxt; cA = nA; cB = nB; ++ui;
        if constexpr (ALIGN_EPI) { if (wr == 1) PG8_BAR; }
    }
    PG8_WAIT_V(0);
    if constexpr (!ALIGN_EPI) { if (wr == 0) PG8_BAR; }
    PG8_BAR;
    if constexpr (Epi::AFTER_DRAIN) { E.fused(acc, cur, wr, wc, fr, fq, lds, wid, lane); S.done(cur); }
#undef PG8_SA
#undef PG8_SB
#undef PG8_STAGE
#undef PG8_LDA
#undef PG8_LDB
#undef PG8_MMA
#undef PG8_WAIT_V
#undef PG8_WAIT_L
#undef PG8_BAR
#undef PG8_SCHED
}
}

#define LAS __attribute__((address_space(3)))
typedef unsigned short bf16;
typedef float f32x4 __attribute__((ext_vector_type(4)));
typedef short bf16x8 __attribute__((ext_vector_type(8)));
typedef unsigned u32x4 __attribute__((ext_vector_type(4)));

constexpr int DM = 2048, SEQ = 2048, NBP = 4, MP = 8192, MS = 128, MT = 8320, MPAD = 8448;
constexpr int DA = 1024, HA = 16, ASH = 3200, NCPAD = 8448, ZBW = 5248;
constexpr int HB = 4, HDB = 256;
constexpr int ZB_GA = 0, ZB_Q = 1024, ZB_K = 2048, ZB_V = 3072, ZB_G = 4096;
constexpr size_t MiB = 1u << 20;
constexpr size_t WS_CTL = 0, WS_WINT = 1 * MiB, WS_XN = 34 * MiB, WS_GT = 1 * MiB, WS_WOUTT = 67 * MiB, WS_WGT = 75 * MiB, WS_WPLET = 83 * MiB,
                 WS_PB = 84 * MiB, WS_ROT = 89 * MiB, WS_ZA = 92 * MiB, WS_YA = 92 * MiB, WS_MIX = 125 * MiB, WS_ST = 158 * MiB, WS_ZB = 196 * MiB, WS_PLE = 1 * MiB,
                 WS_OPS = 281 * MiB, WS_OPSS = 473 * MiB, WS_H2 = 281 * MiB, WS_H2B = 347 * MiB, WS_KDT = 476 * MiB, WS_VT = 492 * MiB, WS_RSS = 508 * MiB, WS_END = 509 * MiB, WS_OPSA = 281 * MiB, WS_CH = 377 * MiB, WS_WWBT = 91 * MiB + 512 * 1024, WS_WABT = WS_WWBT + 128 * 1024;
constexpr size_t O_Y = 0, O_WKVP = 17039360, O_SHP = 17301504, O_RETP = 17314304, O_WKVS = 18362880, O_SHS = 26751488, O_RETS = 27161088;
constexpr int LDS_BYTES = 135168;

struct Params { const float* in[25]; float* out; unsigned char* ws; int ph_lo, ph_hi; };
typedef __attribute__((address_space(4))) const Params* KParams;
__device__ __forceinline__ int my_tid(int wv) { unsigned m = ~0u; asm volatile("" : "+s"(m), "+s"(wv)); return wv * 64 + (int)__builtin_amdgcn_mbcnt_hi(m, __builtin_amdgcn_mbcnt_lo(m, 0u)); }
__device__ __forceinline__ const Params& kparams() { auto k = __builtin_amdgcn_kernarg_segment_ptr(); asm volatile("" : "+s"(k)); return *(const Params*)(KParams)k; }
enum { I_XP = 0, I_XS, I_PP, I_PS, I_SWKV, I_SSHIFT, I_SRET, I_GLN, I_WIN, I_MU, I_W0, I_WWB, I_A0, I_WAB, I_KK, I_KA, I_RK, I_GAG, I_GAB, I_GBG, I_GBB, I_WOUT, I_WPLE, I_WGATE, I_GFIN };

typedef float f32x2_t __attribute__((ext_vector_type(2)));
typedef __bf16 bf16x2_t __attribute__((ext_vector_type(2)));
__device__ __forceinline__ unsigned pk2(float lo, float hi) { const f32x2_t v = {lo, hi}; const bf16x2_t r = __builtin_convertvector(v, bf16x2_t); return __builtin_bit_cast(unsigned, r); }
__device__ __forceinline__ unsigned f2bf(float f) { return pk2(f, f) & 0xffffu; }
__device__ __forceinline__ float bf2f(unsigned h) { return __builtin_bit_cast(float, h << 16); }
__device__ __forceinline__ float bflo(unsigned w) { return __builtin_bit_cast(float, w << 16); }
__device__ __forceinline__ float bfhi(unsigned w) { return __builtin_bit_cast(float, w & 0xffff0000u); }
__device__ __forceinline__ float wave_sum(float v) {
#pragma unroll
    for (int o = 1; o < 64; o <<= 1) v += __shfl_xor(v, o);
    return v;
}
__device__ __forceinline__ float sigmoidf_(float x) { return 1.f / (1.f + __expf(-x)); }
__device__ __forceinline__ float siluf_(float x) { return x / (1.f + __expf(-x)); }
__device__ __forceinline__ float gamma_h(int h) { return 1.f - exp2f(-5.f - (float)h); }
__device__ __forceinline__ float gpow(int h, float n) { return (float)exp((double)n * log(1.0 - exp2(-5.0 - (double)h))); }

template <int N> __device__ __forceinline__ float ror_add(float x) {
    const int y = __builtin_amdgcn_update_dpp(0, __builtin_bit_cast(int, x), 0x120 + N, 0xf, 0xf, false);
    return x + __builtin_bit_cast(float, y);
}
__device__ __forceinline__ float row16_sum(float x) { x = ror_add<8>(x); x = ror_add<4>(x); x = ror_add<2>(x); x = ror_add<1>(x); return x; }

__device__ __forceinline__ void p0_transpose_item(const float* W, int K, int N, bf16* WT, LAS float* scr, int item, int lane) {
    const int nblk = N / 32, kb = item / nblk, nb = item % nblk, k0 = 64 * kb, n0 = 32 * nb;
#pragma unroll 8
    for (int i = 0; i < 32; ++i) { const int kk = 2 * i + (lane >> 5); scr[kk * 33 + (lane & 31)] = W[(size_t)(k0 + kk) * N + n0 + (lane & 31)]; }
    asm volatile("s_waitcnt lgkmcnt(0)" ::: "memory");
    const int c = lane & 7;
#pragma unroll
    for (int j = 0; j < 4; ++j) { const int n = (lane >> 3) + 8 * j; const LAS float* s = scr + (8 * c) * 33 + n;
        u32x4 o; o.x = pk2(s[0 * 33], s[1 * 33]); o.y = pk2(s[2 * 33], s[3 * 33]); o.z = pk2(s[4 * 33], s[5 * 33]); o.w = pk2(s[6 * 33], s[7 * 33]);
        *(u32x4*)(WT + (size_t)(n0 + n) * K + k0 + 8 * c) = o; }
    asm volatile("s_waitcnt lgkmcnt(0)" ::: "memory");
}

__device__ __forceinline__ void phase0(const Params& p, LAS unsigned char* lds, const int tid_) {
    const int tid = tid_, lane = tid & 63, wave = tid >> 6;
    const int gw = blockIdx.x * 8 + wave, NGW = gridDim.x * 8;
    unsigned char* ws = p.ws;
    LAS float* scr = (LAS float*)(lds + wave * 16384);
    constexpr int I_IN = 32 * 260, I_O = 32 * 64, I_G = 32 * 64, I_P = 4 * 64, I_L = 32, NIT = I_IN + I_O + I_G + I_P + 2 * I_L;
    for (int it = gw; it < NIT; it += NGW) {
        int r = it;
        if (r < I_IN) { p0_transpose_item(p.in[I_WIN], 2048, 8320, (bf16*)(ws + WS_WINT), scr, r, lane); continue; } r -= I_IN;
        if (r < I_O) { p0_transpose_item(p.in[I_WOUT], 2048, 2048, (bf16*)(ws + WS_WOUTT), scr, r, lane); continue; } r -= I_O;
        if (r < I_G) { p0_transpose_item(p.in[I_WGATE], 2048, 2048, (bf16*)(ws + WS_WGT), scr, r, lane); continue; } r -= I_G;
        if (r < I_P) { p0_transpose_item(p.in[I_WPLE], 256, 2048, (bf16*)(ws + WS_WPLET), scr, r, lane); continue; } r -= I_P;
        if (r < I_L) { p0_transpose_item(p.in[I_WWB], 64, 1024, (bf16*)(ws + WS_WWBT), scr, r, lane); continue; } r -= I_L;
        p0_transpose_item(p.in[I_WAB], 64, 1024, (bf16*)(ws + WS_WABT), scr, r, lane);
    }
    const float* g = p.in[I_GLN];
    for (int row = gw; row < MT; row += NGW) {
        const float* xr = row < MP ? p.in[I_XP] + (size_t)row * DM : p.in[I_XS] + (size_t)(row - MP) * DM;
        f32x4 v[8]; float s = 0.f;
#pragma unroll
        for (int j = 0; j < 8; ++j) { v[j] = ((const f32x4*)xr)[lane + 64 * j]; s += (v[j].x * v[j].x + v[j].y * v[j].y) + (v[j].z * v[j].z + v[j].w * v[j].w); }
        const float rstd = 1.f / sqrtf(wave_sum(s) * (1.f / DM) + 1e-6f);
        unsigned long long* o8 = (unsigned long long*)((bf16*)(ws + WS_XN) + (size_t)row * DM);
#pragma unroll
        for (int j = 0; j < 8; ++j) { const f32x4 gg = ((const f32x4*)g)[lane + 64 * j];
            o8[lane + 64 * j] = (unsigned long long)pk2(v[j].x * rstd * gg.x, v[j].y * rstd * gg.y) | ((unsigned long long)pk2(v[j].z * rstd * gg.z, v[j].w * rstd * gg.w) << 32); }
    }
    for (int row = gw; row < MT; row += NGW) {
        const float* pr = row < MP ? p.in[I_PP] + (size_t)row * 256 : p.in[I_PS] + (size_t)(row - MP) * 256;
        const f32x4 v = ((const f32x4*)pr)[lane];
        ((unsigned long long*)((bf16*)(ws + WS_PB) + (size_t)row * 256))[lane] = (unsigned long long)pk2(v.x, v.y) | ((unsigned long long)pk2(v.z, v.w) << 32);
    }
    {
        float2* tab = (float2*)(ws + WS_ROT);
        const int gt = blockIdx.x * 512 + tid, NT = gridDim.x * 512;
        for (int e = gt; e < 2049 * 128; e += NT) {
            const int pi = e >> 7, i = e & 127;
            const float pos = pi < 2048 ? (float)pi : 16384.f;
            const float lin = (float)i / 127.f;
            const float angle = 1.0f / powf(10000.f, lin);
            const float theta = pos * angle;
            tab[e] = make_float2((float)cos((double)theta), (float)sin((double)theta));
        }
        float* rss = (float*)(ws + WS_RSS);
        for (int e = gt; e < MPAD; e += NT) rss[e] = 0.f;
    }
}

struct Epi1 {
    static constexpr bool PERM = true, AFTER_DRAIN = false;
    bf16* ZA; bf16* ZB; const float2* rot;
    __device__ __forceinline__ void operator()(const pg8::f32x4 (&acc)[2][2][4][2], const pg8::Unit& u, int wr, int wc, int fr, int fq) const {
#pragma unroll
        for (int ai = 0; ai < 2; ++ai)
#pragma unroll
            for (int m = 0; m < 4; ++m) {
                const int row = u.pm * 256 + ai * 128 + wr * 64 + m * 16 + fr;
                if (row >= MT) continue;
                const int pidx = row < MP ? (row & 2047) : 2048;
#pragma unroll
                for (int bj = 0; bj < 2; ++bj) {
                    const int c0 = u.pn * 256 + bj * 128 + wc * 32 + 8 * fq;
                    if (c0 >= 8320) continue;
                    pg8::f32x4 v0 = acc[ai][bj][m][0], v1 = acc[ai][bj][m][1];
                    if (c0 < ASH) { u32x4 w; w.x = pg8::cvt_pk_bf16(v0.x, v0.y); w.y = pg8::cvt_pk_bf16(v0.z, v0.w); w.z = pg8::cvt_pk_bf16(v1.x, v1.y); w.w = pg8::cvt_pk_bf16(v1.z, v1.w); *(u32x4*)(ZA + (size_t)row * ASH + c0) = w; }
                    else {
                        if (c0 >= 4224 && c0 < 6272) {
                            const int dl = (c0 - 4224) & 255;
                            const float2* t = rot + (size_t)pidx * 128 + (dl >> 1);
                            const float sc = c0 >= 5248 ? 0.0625f : 1.f;
                            const float2 t0 = t[0], t1 = t[1], t2 = t[2], t3 = t[3];
                            pg8::f32x4 r0, r1;
                            r0.x = (v0.x * t0.x - v0.y * t0.y) * sc; r0.y = (v0.x * t0.y + v0.y * t0.x) * sc;
                            r0.z = (v0.z * t1.x - v0.w * t1.y) * sc; r0.w = (v0.z * t1.y + v0.w * t1.x) * sc;
                            r1.x = (v1.x * t2.x - v1.y * t2.y) * sc; r1.y = (v1.x * t2.y + v1.y * t2.x) * sc;
                            r1.z = (v1.z * t3.x - v1.w * t3.y) * sc; r1.w = (v1.z * t3.y + v1.w * t3.x) * sc;
                            v0 = r0; v1 = r1;
                        }
                        u32x4 w; w.x = pg8::cvt_pk_bf16(v0.x, v0.y); w.y = pg8::cvt_pk_bf16(v0.z, v0.w); w.z = pg8::cvt_pk_bf16(v1.x, v1.y); w.w = pg8::cvt_pk_bf16(v1.z, v1.w);
                        *(u32x4*)(ZB + (size_t)row * ZBW + (c0 - ASH)) = w;
                    }
                }
            }
    }
};
struct EpiPle {
    static constexpr bool PERM = true, AFTER_DRAIN = false;
    bf16* O;
    __device__ __forceinline__ void operator()(const pg8::f32x4 (&acc)[2][2][4][2], const pg8::Unit& u, int wr, int wc, int fr, int fq) const {
#pragma unroll
        for (int ai = 0; ai < 2; ++ai)
#pragma unroll
            for (int m = 0; m < 4; ++m) {
                const int row = u.pm * 256 + ai * 128 + wr * 64 + m * 16 + fr;
#pragma unroll
                for (int bj = 0; bj < 2; ++bj) {
                    const int c0 = u.pn * 256 + bj * 128 + wc * 32 + 8 * fq;
                    const pg8::f32x4 v0 = acc[ai][bj][m][0], v1 = acc[ai][bj][m][1];
                    u32x4 w; w.x = pg8::cvt_pk_bf16(v0.x, v0.y); w.y = pg8::cvt_pk_bf16(v0.z, v0.w); w.z = pg8::cvt_pk_bf16(v1.x, v1.y); w.w = pg8::cvt_pk_bf16(v1.z, v1.w);
                    *(u32x4*)(O + (size_t)row * DM + c0) = w;
                }
            }
    }
};
struct Epi2 {
    static constexpr bool PERM = true, AFTER_DRAIN = false;
    const float* xp; const float* xs; float* H2; bf16* H2B;
    __device__ __forceinline__ void operator()(const pg8::f32x4 (&acc)[2][2][4][2], const pg8::Unit& u, int wr, int wc, int fr, int fq) const {
#pragma unroll
        for (int ai = 0; ai < 2; ++ai)
#pragma unroll
            for (int m = 0; m < 4; ++m) {
                const int row = u.pm * 256 + ai * 128 + wr * 64 + m * 16 + fr;
                if (row >= MT) continue;
                const float* xr = row < MP ? xp + (size_t)row * DM : xs + (size_t)(row - MP) * DM;
#pragma unroll
                for (int bj = 0; bj < 2; ++bj) {
                    const int c0 = u.pn * 256 + bj * 128 + wc * 32 + 8 * fq;
                    const pg8::f32x4 v0 = acc[ai][bj][m][0] + *(const pg8::f32x4*)(xr + c0), v1 = acc[ai][bj][m][1] + *(const pg8::f32x4*)(xr + c0 + 4);
                    u32x4 w; w.x = pg8::cvt_pk_bf16(v0.x, v0.y); w.y = pg8::cvt_pk_bf16(v0.z, v0.w); w.z = pg8::cvt_pk_bf16(v1.x, v1.y); w.w = pg8::cvt_pk_bf16(v1.z, v1.w);
                    *(u32x4*)(H2B + (size_t)row * DM + c0) = w;
                }
            }
    }
};
struct Epi3 {
    static constexpr bool PERM = true, AFTER_DRAIN = false;
    const bf16* H2B; const bf16* PLE; bf16* H3; float* rss;
    __device__ __forceinline__ void operator()(const pg8::f32x4 (&acc)[2][2][4][2], const pg8::Unit& u, int wr, int wc, int fr, int fq) const {
#pragma unroll
        for (int ai = 0; ai < 2; ++ai)
#pragma unroll
            for (int m = 0; m < 4; ++m) {
                const int row = u.pm * 256 + ai * 128 + wr * 64 + m * 16 + fr;
                const bool ok = row < MT;
                float ss = 0.f;
#pragma unroll
                for (int bj = 0; bj < 2; ++bj) {
                    const int c0 = u.pn * 256 + bj * 128 + wc * 32 + 8 * fq;
                    if (ok) {
                        const pg8::f32x4 a0 = acc[ai][bj][m][0], a1 = acc[ai][bj][m][1];
                        const u32x4 hw = *(const u32x4*)(H2B + (size_t)row * DM + c0);
                        const pg8::f32x4 h0 = (pg8::f32x4){bflo(hw.x), bfhi(hw.x), bflo(hw.y), bfhi(hw.y)}, h1 = (pg8::f32x4){bflo(hw.z), bfhi(hw.z), bflo(hw.w), bfhi(hw.w)};
                        const u32x4 pw = *(const u32x4*)(PLE + (size_t)row * DM + c0);
                        pg8::f32x4 o0, o1;
                        o0.x = h0.x + sigmoidf_(a0.x) * bflo(pw.x); o0.y = h0.y + sigmoidf_(a0.y) * bfhi(pw.x);
                        o0.z = h0.z + sigmoidf_(a0.z) * bflo(pw.y); o0.w = h0.w + sigmoidf_(a0.w) * bfhi(pw.y);
                        o1.x = h1.x + sigmoidf_(a1.x) * bflo(pw.z); o1.y = h1.y + sigmoidf_(a1.y) * bfhi(pw.z);
                        o1.z = h1.z + sigmoidf_(a1.z) * bflo(pw.w); o1.w = h1.w + sigmoidf_(a1.w) * bfhi(pw.w);
                        { u32x4 w; w.x = pg8::cvt_pk_bf16(o0.x, o0.y); w.y = pg8::cvt_pk_bf16(o0.z, o0.w); w.z = pg8::cvt_pk_bf16(o1.x, o1.y); w.w = pg8::cvt_pk_bf16(o1.z, o1.w); *(u32x4*)(H3 + (size_t)row * DM + c0) = w; }
                        ss += (o0.x * o0.x + o0.y * o0.y) + (o0.z * o0.z + o0.w * o0.w) + (o1.x * o1.x + o1.y * o1.y) + (o1.z * o1.z + o1.w * o1.w);
                    }
                }
                ss += __shfl_xor(ss, 16); ss += __shfl_xor(ss, 32);
                if (ok && fq == 0) atomicAdd(rss + row, ss);
            }
    }
};

__device__ __forceinline__ f32x4 ldz4(const bf16* q) { const unsigned long long w = *(const unsigned long long*)q; return (f32x4){bflo((unsigned)w), bfhi((unsigned)w), bflo((unsigned)(w >> 32)), bfhi((unsigned)(w >> 32))}; }
__device__ __forceinline__ f32x4 za_xs4(const Params& p, const bf16* ZA, int row, int col) {
    const f32x4 f = ldz4(ZA + (size_t)row * ASH + col), mu = *(const f32x4*)(p.in[I_MU] + col);
    f32x4 pv;
    if (row < MP) { if (row & 2047) pv = ldz4(ZA + (size_t)(row - 1) * ASH + col); else pv = (f32x4){0.f, 0.f, 0.f, 0.f}; }
    else pv = *(const f32x4*)(p.in[I_SSHIFT] + (size_t)(row - MP) * ASH + col);
    return f + mu * (pv - f);
}
__device__ __forceinline__ void prep_item(const Params& p, int item, LAS unsigned char* lds, const int tid_) {
    const int tid = tid_, wave = tid >> 6, lane = tid & 63, fr = lane & 15, fq = lane >> 4;
    const int row0 = item * 16;
    const bf16* ZA = (const bf16*)(p.ws + WS_ZA);
    LAS float* lw = (LAS float*)lds;
    LAS float* la = lw + 16 * 512;
    LAS bf16* xwb = (LAS bf16*)(lds + 65536);
    LAS bf16* xab = xwb + 16 * 72;
    {
        const int tok = tid >> 5, j4 = (tid & 31) * 4;
        const f32x4 xs = za_xs4(p, ZA, row0 + tok, 3072 + j4);
        if (j4 < 64) *(LAS unsigned long long*)(xwb + tok * 72 + j4) = (unsigned long long)pk2(tanhf(xs.x), tanhf(xs.y)) | ((unsigned long long)pk2(tanhf(xs.z), tanhf(xs.w)) << 32);
        else *(LAS unsigned long long*)(xab + tok * 72 + j4 - 64) = (unsigned long long)pk2(xs.x, xs.y) | ((unsigned long long)pk2(xs.z, xs.w) << 32);
    }
    __syncthreads();
    bf16x8 aw[2], aa[2];
#pragma unroll
    for (int ks = 0; ks < 2; ++ks) { aw[ks] = *(LAS const bf16x8*)(xwb + fr * 72 + ks * 32 + fq * 8); aa[ks] = *(LAS const bf16x8*)(xab + fr * 72 + ks * 32 + fq * 8); }
    const bf16* WWT = (const bf16*)(p.ws + WS_WWBT); const bf16* WAT = (const bf16*)(p.ws + WS_WABT);
#pragma unroll 1
    for (int hp = 0; hp < 2; ++hp) {
        {
            const int chb = hp * 512 + wave * 64;
            bf16x8 bw[4][2], ba[4][2];
#pragma unroll
            for (int n = 0; n < 4; ++n)
#pragma unroll
                for (int ks = 0; ks < 2; ++ks) { bw[n][ks] = *(const bf16x8*)(WWT + (size_t)(chb + n * 16 + fr) * 64 + ks * 32 + fq * 8); ba[n][ks] = *(const bf16x8*)(WAT + (size_t)(chb + n * 16 + fr) * 64 + ks * 32 + fq * 8); }
            __builtin_amdgcn_sched_barrier(0);
#pragma unroll
            for (int n = 0; n < 4; ++n) {
                f32x4 cw = (f32x4){0.f, 0.f, 0.f, 0.f}, ca = (f32x4){0.f, 0.f, 0.f, 0.f};
#pragma unroll
                for (int ks = 0; ks < 2; ++ks) { cw = __builtin_amdgcn_mfma_f32_16x16x32_bf16(aw[ks], bw[n][ks], cw, 0, 0, 0); ca = __builtin_amdgcn_mfma_f32_16x16x32_bf16(aa[ks], ba[n][ks], ca, 0, 0, 0); }
#pragma unroll
                for (int r = 0; r < 4; ++r) { lw[(4 * fq + r) * 512 + wave * 64 + n * 16 + fr] = cw[r]; la[(4 * fq + r) * 512 + wave * 64 + n * 16 + fr] = ca[r]; }
            }
        }
        __syncthreads();
#pragma unroll 1
        for (int it2 = 0; it2 < 2; ++it2) {
            f32x4 r4[2], k4[2], v4[2];
#pragma unroll
            for (int u = 0; u < 2; ++u) {
                const int e = (it2 * 2 + u) * 512 + tid, tok = e >> 7, ch = hp * 512 + (e & 127) * 4, row = row0 + tok;
                r4[u] = za_xs4(p, ZA, row, ch); k4[u] = za_xs4(p, ZA, row, 1024 + ch); v4[u] = za_xs4(p, ZA, row, 2048 + ch);
            }
            __builtin_amdgcn_sched_barrier(0);
#pragma unroll
            for (int u = 0; u < 2; ++u) {
                const int e = (it2 * 2 + u) * 512 + tid, tok = e >> 7, chl = (e & 127) * 4, ch = hp * 512 + chl, h = ch >> 6, c4 = ch & 63, row = row0 + tok;
                const f32x4 lwv = *(LAS const f32x4*)(lw + tok * 512 + chl) + *(const f32x4*)(p.in[I_W0] + ch);
                const f32x4 lav = *(LAS const f32x4*)(la + tok * 512 + chl) + *(const f32x4*)(p.in[I_A0] + ch);
                const f32x4 kkw = *(const f32x4*)(p.in[I_KK] + ch), kaw = *(const f32x4*)(p.in[I_KA] + ch);
                f32x4 dec, av, kk, k2;
#pragma unroll
                for (int i = 0; i < 4; ++i) {
                    const float nx = -lwv[i];
                    const float sp = fmaxf(nx, 0.f) + __logf(1.f + __expf(-fabsf(nx)));
                    dec[i] = __expf(-__expf(-sp - 0.5f));
                    av[i] = 1.f / (1.f + __expf(-lav[i]));
                    kk[i] = k4[u][i] * kkw[i];
                    k2[i] = k4[u][i] * (1.f + (av[i] - 1.f) * kaw[i]);
                }
                const float nrm = fmaxf(sqrtf(row16_sum((kk.x * kk.x + kk.y * kk.y) + (kk.z * kk.z + kk.w * kk.w))), 1e-12f);
                kk = kk * (1.f / nrm);
                float* base = row < MP ? (float*)(p.ws + WS_OPS) + ((size_t)((row >> 11) * 16 + h) * 2048 + (row & 2047)) * 384
                                       : (float*)(p.ws + WS_OPSS) + ((size_t)(row - MP) * 16 + h) * 384;
                *(f32x4*)(base + c4) = dec; *(f32x4*)(base + 64 + c4) = -kk; *(f32x4*)(base + 128 + c4) = kk * av; *(f32x4*)(base + 192 + c4) = k2; *(f32x4*)(base + 256 + c4) = r4[u]; *(f32x4*)(base + 320 + c4) = v4[u];
            }
        }
        __syncthreads();
    }
}
constexpr int CH_X1 = 0, CH_X2 = 4096, CH_X3 = 5120, CH_WC = 9216, CH_VP = 9472, CH_BYTES = 12288;
__device__ __forceinline__ float wave64_sum(float x) {
    x = row16_sum(x);
    x += __builtin_bit_cast(float, __builtin_amdgcn_update_dpp(0, __builtin_bit_cast(int, x), 0x142, 0xa, 0xf, false));
    x += __builtin_bit_cast(float, __builtin_amdgcn_update_dpp(0, __builtin_bit_cast(int, x), 0x143, 0xc, 0xf, false));
    return __builtin_bit_cast(float, __builtin_amdgcn_readlane(__builtin_bit_cast(int, x), 63));
}
__device__ __forceinline__ void prompt_head(const Params& p, int row0, int h, LAS unsigned char* scr, const bf16x8 (&aw)[2], const bf16x8 (&aa)[2], int lane) {
    const int fr = lane & 15, fq = lane >> 4, c = lane, ch = h * 64 + c;
    const int b = row0 >> 11, t0 = row0 & 2047, bh = b * 16 + h;
    const bf16* ZA = (const bf16*)(p.ws + WS_ZA);
    unsigned short zr_[16], zk_[16], zv_[16];
#pragma unroll
    for (int t = 0; t < 16; ++t) { const bf16* z = ZA + (size_t)(row0 + t) * ASH + ch; zr_[t] = z[0]; zk_[t] = z[1024]; zv_[t] = z[2048]; }
    LAS float* lwla = (LAS float*)scr;
    {
        const bf16* WWT = (const bf16*)(p.ws + WS_WWBT) + (size_t)(h * 64 + fr) * 64 + fq * 8; const bf16* WAT = (const bf16*)(p.ws + WS_WABT) + (size_t)(h * 64 + fr) * 64 + fq * 8;
        bf16x8 bw[4][2], ba[4][2];
#pragma unroll
        for (int n = 0; n < 4; ++n)
#pragma unroll
            for (int ks = 0; ks < 2; ++ks) { bw[n][ks] = *(const bf16x8*)(WWT + n * 1024 + ks * 32); ba[n][ks] = *(const bf16x8*)(WAT + n * 1024 + ks * 32); }
#pragma unroll
        for (int n = 0; n < 4; ++n) {
            f32x4 cw = (f32x4){0.f, 0.f, 0.f, 0.f}, ca = (f32x4){0.f, 0.f, 0.f, 0.f};
#pragma unroll
            for (int ks = 0; ks < 2; ++ks) { cw = __builtin_amdgcn_mfma_f32_16x16x32_bf16(aw[ks], bw[n][ks], cw, 0, 0, 0); ca = __builtin_amdgcn_mfma_f32_16x16x32_bf16(aa[ks], ba[n][ks], ca, 0, 0, 0); }
#pragma unroll
            for (int r = 0; r < 4; ++r) { lwla[(4 * fq + r) * 64 + n * 16 + fr] = cw[r]; lwla[1024 + (4 * fq + r) * 64 + n * 16 + fr] = ca[r]; }
        }
    }
    const float w0 = p.in[I_W0][ch], a0 = p.in[I_A0][ch], kkw = p.in[I_KK][ch], kaw = p.in[I_KA][ch];
    const float mur = p.in[I_MU][ch], muk = p.in[I_MU][1024 + ch], muv = p.in[I_MU][2048 + ch];
    float pr = 0.f, pk = 0.f, pv = 0.f;
    if (t0) { const bf16* zp = ZA + (size_t)(row0 - 1) * ASH + ch; pr = bf2f(zp[0]); pk = bf2f(zp[1024]); pv = bf2f(zp[2048]); }
    float At[16], Rt[16], Bt[16], Kt[16], Vt[16];
    float Wc = 1.f;
    bf16* vbp = (bf16*)(p.ws + WS_OPSA) + (size_t)row0 * DA + ch;
    const float rkw = p.in[I_RK][ch];
#pragma unroll
    for (int tb = 0; tb < 16; tb += 4) {
    float fr_[4], fk_[4], fv_[4];
#pragma unroll
    for (int t = 0; t < 4; ++t) { fr_[t] = bf2f(zr_[tb + t]); fk_[t] = bf2f(zk_[tb + t]); fv_[t] = bf2f(zv_[tb + t]); }
#pragma unroll
    for (int tt = 0; tt < 4; ++tt) {
        const int t = tb + tt;
        const float xr = fr_[tt] + mur * (pr - fr_[tt]), xk = fk_[tt] + muk * (pk - fk_[tt]), xv = fv_[tt] + muv * (pv - fv_[tt]);
        pr = fr_[tt]; pk = fk_[tt]; pv = fv_[tt];
        const float lwv = lwla[t * 64 + c] + w0, lav = lwla[1024 + t * 64 + c] + a0;
        const float nx = -lwv;
        const float sp = fmaxf(nx, 0.f) + __logf(1.f + __expf(-fabsf(nx)));
        const float dec = __expf(-__expf(-sp - 0.5f));
        const float av = __builtin_amdgcn_rcpf(1.f + __expf(-lav));
        float kk = xk * kkw;
        const float nrm = fmaxf(__builtin_amdgcn_sqrtf(wave64_sum(kk * kk)), 1e-12f);
        kk = kk * __builtin_amdgcn_rcpf(nrm);
        const float k2 = xk * (1.f + (av - 1.f) * kaw);
        const float Wprev = Wc; Wc *= dec;
        const float inv = __builtin_amdgcn_rcpf(Wc);
        At[t] = -kk * Wprev; Rt[t] = xr * Wc; Bt[t] = kk * av * inv; Kt[t] = k2 * inv; Vt[t] = xv;
        { const float bs = wave64_sum(xr * k2 * rkw); vbp[(size_t)t * DA] = (bf16)f2bf(xv * bs); }
    }
    __builtin_amdgcn_sched_barrier(0);
    }
    __builtin_amdgcn_sched_barrier(0);
    LAS bf16* ARt = (LAS bf16*)scr; LAS bf16* BKt = ARt + 32 * 64;
#pragma unroll
    for (int t = 0; t < 16; ++t) { ARt[t * 64 + c] = (bf16)f2bf(At[t]); ARt[(16 + t) * 64 + c] = (bf16)f2bf(Rt[t]); BKt[t * 64 + c] = (bf16)f2bf(Bt[t]); BKt[(16 + t) * 64 + c] = (bf16)f2bf(Kt[t]); }
    unsigned char* rec = p.ws + WS_CH + ((size_t)bh * 128 + (t0 >> 4)) * CH_BYTES;
    {
        u32x4* x3 = (u32x4*)(rec + CH_X3);
#pragma unroll
        for (int f = 0; f < 4; ++f) {
            u32x4 w; w.x = pk2(Bt[4 * f], Bt[4 * f + 1]); w.y = pk2(Bt[4 * f + 2], Bt[4 * f + 3]); w.z = pk2(Kt[4 * f], Kt[4 * f + 1]); w.w = pk2(Kt[4 * f + 2], Kt[4 * f + 3]);
            x3[((c >> 4) * 4 + f) * 16 + (c & 15)] = w;
        }
        ((float*)(rec + CH_WC))[((c >> 2) & 3) * 16 + (c >> 4) * 4 + (c & 3)] = Wc;
        unsigned long long* vp = (unsigned long long*)(rec + CH_VP);
#pragma unroll
        for (int f = 0; f < 4; ++f) vp[f * 64 + c] = (unsigned long long)pk2(Vt[4 * f], Vt[4 * f + 1]) | ((unsigned long long)pk2(Vt[4 * f + 2], Vt[4 * f + 3]) << 32);
    }
    f32x4 D[2][2];
    {
        bf16x8 fa[2][2], fb[2][2];
#pragma unroll
        for (int m = 0; m < 2; ++m)
#pragma unroll
            for (int ks = 0; ks < 2; ++ks) { fa[m][ks] = *(LAS const bf16x8*)(BKt + (m * 16 + fr) * 64 + ks * 32 + fq * 8); fb[m][ks] = *(LAS const bf16x8*)(ARt + (m * 16 + fr) * 64 + ks * 32 + fq * 8); }
#pragma unroll
        for (int m = 0; m < 2; ++m)
#pragma unroll
            for (int n = 0; n < 2; ++n) {
                f32x4 d = (f32x4){0.f, 0.f, 0.f, 0.f};
#pragma unroll
                for (int ks = 0; ks < 2; ++ks) d = __builtin_amdgcn_mfma_f32_16x16x32_bf16(fa[m][ks], fb[n][ks], d, 0, 0, 0);
                D[m][n] = d;
            }
    }
    asm volatile("s_waitcnt lgkmcnt(0)" ::: "memory");
    LAS float* Mab = (LAS float*)scr; LAS float* Mak = Mab + 256; LAS float* Mbr = Mab + 512; LAS float* Mkr = Mab + 768; LAS float* Tm = Mab + 1024; LAS float* P1m = Mab + 1280;
#pragma unroll
    for (int r = 0; r < 4; ++r) {
        const int i = 4 * fq + r, t = fr;
        Mab[i * 16 + t] = i < t ? D[0][0][r] : 0.f; Mbr[i * 16 + t] = i <= t ? D[0][1][r] : 0.f;
        Mak[i * 16 + t] = i < t ? D[1][0][r] : 0.f; Mkr[i * 16 + t] = i <= t ? D[1][1][r] : 0.f;
    }
    __builtin_amdgcn_sched_barrier(0);
    {
        float Tj[16];
#pragma unroll
        for (int t = 0; t < 16; ++t) Tj[t] = (fr == t) ? 1.f : 0.f;
#pragma unroll
        for (int i = 0; i < 15; ++i) {
            float row[16];
#pragma unroll
            for (int q4 = 0; q4 < 4; ++q4) { const f32x4 v = *(LAS const f32x4*)(Mab + i * 16 + q4 * 4); row[q4 * 4] = v.x; row[q4 * 4 + 1] = v.y; row[q4 * 4 + 2] = v.z; row[q4 * 4 + 3] = v.w; }
#pragma unroll
            for (int t = i + 1; t < 16; ++t) Tj[t] += Tj[i] * row[t];
        }
        if (lane < 16) {
#pragma unroll
            for (int q4 = 0; q4 < 4; ++q4) *(LAS f32x4*)(Tm + lane * 16 + q4 * 4) = (f32x4){Tj[q4 * 4], Tj[q4 * 4 + 1], Tj[q4 * 4 + 2], Tj[q4 * 4 + 3]};
        }
    }
    {
        const int i = fr, tq = fq;
        f32x4 p1 = (f32x4){0.f, 0.f, 0.f, 0.f};
#pragma unroll
        for (int j = 0; j < 16; ++j) p1 += *(LAS const f32x4*)(Tm + j * 16 + tq * 4) * Mak[i * 16 + j];
        *(LAS f32x4*)(P1m + i * 16 + tq * 4) = p1;
        f32x4 g = *(LAS const f32x4*)(Mkr + i * 16 + tq * 4);
#pragma unroll
        for (int j = 0; j < 16; ++j) g += *(LAS const f32x4*)(Mbr + j * 16 + tq * 4) * P1m[i * 16 + j];
        bf16* x2 = (bf16*)(rec + CH_X2);
#pragma unroll
        for (int jj = 0; jj < 4; ++jj) {
            x2[(((i >> 2)) * 16 + 4 * tq + jj) * 4 + (i & 3)] = (bf16)f2bf(p1[jj]);
            x2[((4 + (i >> 2)) * 16 + 4 * tq + jj) * 4 + (i & 3)] = (bf16)f2bf(g[jj]);
        }
    }
    __builtin_amdgcn_sched_barrier(0);
    {
        const int k = c, ks = k >> 5, j = ((k >> 4) & 1) * 4 + (k & 3), fqk = (k >> 2) & 3;
        bf16* x1 = (bf16*)(rec + CH_X1) + ((ks * 4 + fqk) * 32) * 8 + j;
        float Qh[16];
#pragma unroll
        for (int t = 0; t < 16; ++t) Qh[t] = Rt[t];
#pragma unroll 1
        for (int t = 0; t < 16; ++t) {
            float at = 0.f;
#pragma unroll
            for (int i = 0; i < 16; ++i) at += At[i] * Tm[i * 16 + t];
            x1[t * 8] = (bf16)f2bf(at);
#pragma unroll
            for (int q4 = 0; q4 < 4; ++q4) { const f32x4 v = *(LAS const f32x4*)(Mbr + t * 16 + q4 * 4); Qh[q4 * 4] += at * v.x; Qh[q4 * 4 + 1] += at * v.y; Qh[q4 * 4 + 2] += at * v.z; Qh[q4 * 4 + 3] += at * v.w; }
        }
#pragma unroll
        for (int t = 0; t < 16; ++t) x1[(16 + t) * 8] = (bf16)f2bf(Qh[t]);
    }
    asm volatile("s_waitcnt lgkmcnt(0)" ::: "memory");
}
__device__ __forceinline__ void prompt_item(const Params& p, int item, LAS unsigned char* lds, const int tid_) {
    const int tid = tid_, wave = __builtin_amdgcn_readfirstlane(tid >> 6), lane = tid & 63, fr = lane & 15, fq = lane >> 4;
    const int row0 = item * 16;
    const bf16* ZA = (const bf16*)(p.ws + WS_ZA);
    LAS bf16* xwb = (LAS bf16*)(lds + 65536); LAS bf16* xab = xwb + 16 * 72;
    {
        const int tok = tid >> 5, j4 = (tid & 31) * 4;
        const f32x4 xs = za_xs4(p, ZA, row0 + tok, 3072 + j4);
        if (j4 < 64) *(LAS unsigned long long*)(xwb + tok * 72 + j4) = (unsigned long long)pk2(tanhf(xs.x), tanhf(xs.y)) | ((unsigned long long)pk2(tanhf(xs.z), tanhf(xs.w)) << 32);
        else *(LAS unsigned long long*)(xab + tok * 72 + j4 - 64) = (unsigned long long)pk2(xs.x, xs.y) | ((unsigned long long)pk2(xs.z, xs.w) << 32);
    }
    __syncthreads();
    bf16x8 aw[2], aa[2];
#pragma unroll
    for (int ks = 0; ks < 2; ++ks) { aw[ks] = *(LAS const bf16x8*)(xwb + fr * 72 + ks * 32 + fq * 8); aa[ks] = *(LAS const bf16x8*)(xab + fr * 72 + ks * 32 + fq * 8); }
#pragma unroll 1
    for (int hh = 0; hh < 2; ++hh) prompt_head(p, row0, wave * 2 + hh, lds + wave * 8192, aw, aa, lane);
    __syncthreads();
}
__device__ __forceinline__ void tr_item(const Params& p, int item, LAS unsigned char* lds, const int tid_) {
    const int tid = tid_;
    const int which = item & 1, tt = (item >> 1) & 31, bh = item >> 6, b = bh >> 2, h = bh & 3;
    const bf16* ZB = (const bf16*)(p.ws + WS_ZB);
    LAS bf16* tile = (LAS bf16*)lds;
    const int t0 = tt * 64;
    const float lg = logf(gamma_h(h));
    for (int e = tid; e < 2048; e += 512) {
        const int t = e >> 5, dc = e & 31;
        const u32x4 w = *(const u32x4*)(ZB + (size_t)(b * 2048 + t0 + t) * ZBW + (which ? ZB_V : ZB_K) + h * 256 + dc * 8);
        unsigned ww[4] = {w.x, w.y, w.z, w.w};
        float sc = 1.f;
        if (!which) sc = expf((float)(127 - ((t0 + t) & 127)) * lg);
#pragma unroll
        for (int i = 0; i < 4; ++i) {
            tile[t * 258 + dc * 8 + 2 * i] = (bf16)f2bf(bflo(ww[i]) * sc);
            tile[t * 258 + dc * 8 + 2 * i + 1] = (bf16)f2bf(bfhi(ww[i]) * sc);
        }
    }
    __syncthreads();
    bf16* dst = (bf16*)(p.ws + (which ? WS_VT : WS_KDT)) + (size_t)bh * 256 * 2048;
    for (int e = tid; e < 2048; e += 512) {
        const int d = e >> 3, tc = e & 7;
        unsigned o[4];
#pragma unroll
        for (int i = 0; i < 4; ++i) o[i] = (unsigned)tile[(tc * 8 + 2 * i) * 258 + d] | ((unsigned)tile[(tc * 8 + 2 * i + 1) * 258 + d] << 16);
        u32x4 w; w.x = o[0]; w.y = o[1]; w.z = o[2]; w.w = o[3];
        *(u32x4*)(dst + (size_t)d * 2048 + t0 + tc * 8) = w;
    }
    __syncthreads();
}
__device__ __forceinline__ void phase2(const Params& p, LAS unsigned char* lds, const int tid_) {
    for (int it = blockIdx.x; it < 512; it += gridDim.x) prompt_item(p, it, lds, tid_);
    if (gridDim.x > 16) {
        if (blockIdx.x < 8) prep_item(p, 512 + blockIdx.x, lds, tid_);
        else for (int it = blockIdx.x - 8; it < 1024; it += gridDim.x - 8) tr_item(p, it, lds, tid_);
    } else {
        for (int it = 512 + blockIdx.x; it < 520; it += gridDim.x) prep_item(p, it, lds, tid_);
        for (int it = blockIdx.x; it < 1024; it += gridDim.x) tr_item(p, it, lds, tid_);
    }
    const bf16* ZA = (const bf16*)(p.ws + WS_ZA);
    const int gt = blockIdx.x * 512 + tid_, NT = gridDim.x * 512;
    for (int e = gt; e < 4 * ASH; e += NT) { const int b = e / ASH, c = e % ASH; p.out[O_SHP + e] = bf2f(ZA[(size_t)(b * 2048 + 2047) * ASH + c]); }
    for (int e = gt; e < MS * ASH; e += NT) { p.out[O_SHS + e] = bf2f(ZA[(size_t)MP * ASH + e]); }
}

constexpr int CR_NS = 8, CR_FULL = CR_NS * CH_BYTES, CR_DONE = CR_FULL + 64;
#define GLDS16(src, dst) __builtin_amdgcn_global_load_lds((const unsigned*)(src), (LAS unsigned*)(dst), 16, 0, 0)
__device__ __forceinline__ void chunk_loader(const unsigned char* rec, LAS unsigned char* lds, int lw, int lane) {
    LAS unsigned* FULL = (LAS unsigned*)(lds + CR_FULL); volatile LAS unsigned* DONE = (volatile LAS unsigned*)(lds + CR_DONE);
    int pub = 0;
    for (int q = 0; q < 128; ++q) {
        const int s = q % CR_NS;
        if (q >= CR_NS) {
            const unsigned need = 4u * (unsigned)(q / CR_NS);
            if (DONE[s] < need && pub < q) { asm volatile("s_waitcnt vmcnt(0)" ::: "memory"); for (; pub < q; ++pub) { if (lane == 0) __hip_atomic_fetch_add(FULL + pub % CR_NS, 1u, __ATOMIC_RELAXED, __HIP_MEMORY_SCOPE_WORKGROUP); } }
            while (DONE[s] < need) __builtin_amdgcn_s_sleep(1);
            __builtin_amdgcn_fence(__ATOMIC_ACQUIRE, "workgroup");
        }
        const unsigned char* src = rec + (size_t)q * CH_BYTES + lw * 3072 + lane * 16;
        LAS unsigned char* dst = lds + s * CH_BYTES + lw * 3072;
#pragma unroll
        for (int i = 0; i < 3; ++i) GLDS16(src + i * 1024, dst + i * 1024);
        if (q >= 5 && pub < q - 4) { asm volatile("s_waitcnt vmcnt(15)" ::: "memory"); if (lane == 0) __hip_atomic_fetch_add(FULL + pub % CR_NS, 1u, __ATOMIC_RELAXED, __HIP_MEMORY_SCOPE_WORKGROUP); ++pub; }
    }
    asm volatile("s_waitcnt vmcnt(0)" ::: "memory");
    for (; pub < 128; ++pub) { if (lane == 0) __hip_atomic_fetch_add(FULL + pub % CR_NS, 1u, __ATOMIC_RELAXED, __HIP_MEMORY_SCOPE_WORKGROUP); }
}
__device__ __forceinline__ void chunk_scan(const Params& p, int bh, int wv, int lane, LAS unsigned char* lds) {
    const int fr = lane & 15, fq = lane >> 4, b = bh >> 4, h = bh & 15;
    volatile LAS unsigned* FULL = (volatile LAS unsigned*)(lds + CR_FULL); LAS unsigned* DONE = (LAS unsigned*)(lds + CR_DONE);
    float* yp = (float*)(p.ws + WS_YA) + (size_t)(b * 2048 + 4 * fq) * DA + h * 64 + wv * 16 + fr;
    f32x4 S[4];
#pragma unroll
    for (int m = 0; m < 4; ++m) S[m] = (f32x4){0.f, 0.f, 0.f, 0.f};
#pragma unroll 1
    for (int ck = 0; ck < 128; ++ck) {
        const int s = ck % CR_NS;
        const unsigned need = 4u * (unsigned)(ck / CR_NS + 1);
        while (FULL[s] < need) {}
        __builtin_amdgcn_fence(__ATOMIC_ACQUIRE, "workgroup");
        LAS const unsigned char* r_ = lds + s * CH_BYTES;
        bf16x8 X1[2][2], X3[4]; unsigned long long X2[2], V4; f32x4 Wc[4];
#pragma unroll
        for (int mt = 0; mt < 2; ++mt)
#pragma unroll
            for (int ks = 0; ks < 2; ++ks) X1[mt][ks] = *(LAS const bf16x8*)(r_ + CH_X1 + (((ks * 4 + fq) * 32 + mt * 16 + fr) * 8) * 2);
#pragma unroll
        for (int mt = 0; mt < 2; ++mt) X2[mt] = *(LAS const unsigned long long*)(r_ + CH_X2 + (((mt * 4 + fq) * 16 + fr) * 4) * 2);
#pragma unroll
        for (int mt = 0; mt < 4; ++mt) X3[mt] = *(LAS const bf16x8*)(r_ + CH_X3 + (((mt * 4 + fq) * 16 + fr) * 8) * 2);
#pragma unroll
        for (int mt = 0; mt < 4; ++mt) Wc[mt] = *(LAS const f32x4*)(r_ + CH_WC + (fq * 16 + mt * 4) * 4);
        V4 = *(LAS const unsigned long long*)(r_ + CH_VP + ((fq * 64 + wv * 16 + fr) * 4) * 2);
        bf16x8 Sb[2], Vb, X2f[2];
#pragma unroll
        for (int ks = 0; ks < 2; ++ks) {
            u32x4 w; w.x = pk2(S[2 * ks].x, S[2 * ks].y); w.y = pk2(S[2 * ks].z, S[2 * ks].w); w.z = pk2(S[2 * ks + 1].x, S[2 * ks + 1].y); w.w = pk2(S[2 * ks + 1].z, S[2 * ks + 1].w);
            Sb[ks] = __builtin_bit_cast(bf16x8, w);
        }
        { u32x4 w; w.x = (unsigned)V4; w.y = (unsigned)(V4 >> 32); w.z = 0u; w.w = 0u; Vb = __builtin_bit_cast(bf16x8, w); }
#pragma unroll
        for (int mt = 0; mt < 2; ++mt) { u32x4 w; w.x = (unsigned)X2[mt]; w.y = (unsigned)(X2[mt] >> 32); w.z = 0u; w.w = 0u; X2f[mt] = __builtin_bit_cast(bf16x8, w); }
        asm volatile("s_waitcnt lgkmcnt(0)" ::: "memory");
        if (lane == 0) __hip_atomic_fetch_add(DONE + s, 1u, __ATOMIC_RELAXED, __HIP_MEMORY_SCOPE_WORKGROUP);
        f32x4 D1[2];
#pragma unroll
        for (int mt = 0; mt < 2; ++mt) {
            f32x4 d = (f32x4){0.f, 0.f, 0.f, 0.f};
            d = __builtin_amdgcn_mfma_f32_16x16x32_bf16(X1[mt][0], Sb[0], d, 0, 0, 0);
            d = __builtin_amdgcn_mfma_f32_16x16x32_bf16(X1[mt][1], Sb[1], d, 0, 0, 0);
            d = __builtin_amdgcn_mfma_f32_16x16x32_bf16(X2f[mt], Vb, d, 0, 0, 0);
            D1[mt] = d;
        }
        bf16x8 SAV;
        { u32x4 w; w.x = pk2(D1[0].x, D1[0].y); w.y = pk2(D1[0].z, D1[0].w); w.z = (unsigned)V4; w.w = (unsigned)(V4 >> 32); SAV = __builtin_bit_cast(bf16x8, w); }
        f32x4 D2[4];
#pragma unroll
        for (int mt = 0; mt < 4; ++mt) D2[mt] = __builtin_amdgcn_mfma_f32_16x16x32_bf16(X3[mt], SAV, (f32x4){0.f, 0.f, 0.f, 0.f}, 0, 0, 0);
#pragma unroll
        for (int mt = 0; mt < 4; ++mt) S[mt] = (S[mt] + D2[mt]) * Wc[mt];
        float* y = yp + (size_t)ck * 16 * DA;
        y[0] = D1[1].x; y[DA] = D1[1].y; y[2 * DA] = D1[1].z; y[3 * DA] = D1[1].w;
    }
#pragma unroll
    for (int mt = 0; mt < 4; ++mt) *(f32x4*)(p.out + O_WKVP + ((size_t)bh * 64 + wv * 16 + fr) * 64 + mt * 16 + 4 * fq) = S[mt];
}
__device__ __forceinline__ void stepA_task(const Params& p, int task, int lane) {
    const int bh = task >> 6, dt = (task >> 2) & 15, vq = task & 3, fr = lane & 15, fq = lane >> 4, h = bh & 3;
    const bf16* KT = (const bf16*)(p.ws + WS_KDT) + (size_t)bh * 256 * 2048 + (size_t)(dt * 16 + fr) * 2048 + fq * 8;
    const bf16* VT = (const bf16*)(p.ws + WS_VT) + (size_t)bh * 256 * 2048 + (size_t)(vq * 64 + fr) * 2048 + fq * 8;
    bf16* ST = (bf16*)(p.ws + WS_ST) + ((size_t)(bh * 16) << 16) + (size_t)(vq * 64 + fr) * 256 + dt * 16 + 4 * fq;
    const float g128 = gpow(h, 128.f);
    f32x4 acc[4];
#pragma unroll
    for (int n = 0; n < 4; ++n) acc[n] = (f32x4){0.f, 0.f, 0.f, 0.f};
    bf16x8 FA[8], FB[8][4];
#define SA_LOAD(u_, s_) do { const bf16* ka_ = KT + (s_) * 32; const bf16* vb_ = VT + (s_) * 32; FA[u_] = *(const bf16x8*)ka_; \
        _Pragma("unroll") for (int n = 0; n < 4; ++n) FB[u_][n] = *(const bf16x8*)(vb_ + (size_t)(n * 16) * 2048); } while (0)
#pragma unroll
    for (int u = 0; u < 8; ++u) SA_LOAD(u, u);
#pragma unroll 1
    for (int g = 0; g < 8; ++g) {
#pragma unroll
        for (int u = 0; u < 8; ++u) {
            const int s = g * 8 + u;
            if ((u & 3) == 0) {
                bf16* st = ST + ((size_t)(s >> 2) << 16);
#pragma unroll
                for (int n = 0; n < 4; ++n) {
                    *(unsigned long long*)(st + (size_t)(n * 16) * 256) = (unsigned long long)pk2(acc[n].x, acc[n].y) | ((unsigned long long)pk2(acc[n].z, acc[n].w) << 32);
                    acc[n] = acc[n] * g128;
                }
            }
#pragma unroll
            for (int n = 0; n < 4; ++n) acc[n] = __builtin_amdgcn_mfma_f32_16x16x32_bf16(FA[u], FB[u][n], acc[n], 0, 0, 0);
            { const int sn = s + 8 < 64 ? s + 8 : 63; SA_LOAD(u, sn); }
        }
    }
#undef SA_LOAD
    float* o = p.out + O_RETP + ((size_t)bh << 16) + (size_t)(dt * 16 + 4 * fq) * 256 + vq * 64 + fr;
#pragma unroll
    for (int n = 0; n < 4; ++n)
#pragma unroll
        for (int r = 0; r < 4; ++r) o[(size_t)r * 256 + n * 16] = acc[n][r];
}
__device__ __forceinline__ void wkv_sample_unit(const Params& p, int su, int lane) {
    const float* o = (const float*)(p.ws + WS_OPSS) + (size_t)su * 384;
    const int kq = (lane & 15) * 4, rq = lane >> 4;
    const f32x4* S0 = (const f32x4*)(p.in[I_SWKV] + (size_t)su * 4096) + lane; f32x4* Sn = (f32x4*)(p.out + O_WKVS + (size_t)su * 4096) + lane;
    f32x4 S[16]; float vv[16];
#pragma unroll
    for (int i = 0; i < 16; ++i) { S[i] = S0[i * 64]; vv[i] = o[320 + i * 4 + rq]; }
    const f32x4 w4 = *(const f32x4*)(o + kq), a4 = *(const f32x4*)(o + 64 + kq), b4 = *(const f32x4*)(o + 128 + kq), k4 = *(const f32x4*)(o + 192 + kq), r4 = *(const f32x4*)(o + 256 + kq);
    const int s = su >> 4, h = su & 15;
    float* ya = (float*)(p.ws + WS_YA) + (size_t)(MP + s) * DA + h * 64 + rq;
#pragma unroll
    for (int i = 0; i < 16; ++i) {
        const float dot = row16_sum((S[i].x * a4.x + S[i].y * a4.y) + (S[i].z * a4.z + S[i].w * a4.w));
        const f32x4 sn = S[i] * w4 + b4 * dot + k4 * vv[i];
        Sn[i * 64] = sn;
        const float y = row16_sum((sn.x * r4.x + sn.y * r4.y) + (sn.z * r4.z + sn.w * r4.w));
        if ((lane & 15) == 0) ya[i * 4] = y;
    }
}
__device__ __forceinline__ void ret_sample_task(const Params& p, int su, int lane) {
    const int s = su >> 2, h = su & 3, row = MP + s;
    const bf16* zr = (const bf16*)(p.ws + WS_ZB) + (size_t)row * ZBW;
    const unsigned long long qw = *(const unsigned long long*)(zr + ZB_Q + h * 256 + lane * 4), kw = *(const unsigned long long*)(zr + ZB_K + h * 256 + lane * 4),
                             vw = *(const unsigned long long*)(zr + ZB_V + h * 256 + lane * 4), gw = *(const unsigned long long*)(zr + ZB_G + h * 256 + lane * 4);
    const float q4[4] = {bflo((unsigned)qw), bfhi((unsigned)qw), bflo((unsigned)(qw >> 32)), bfhi((unsigned)(qw >> 32))};
    const float k4[4] = {bflo((unsigned)kw), bfhi((unsigned)kw), bflo((unsigned)(kw >> 32)), bfhi((unsigned)(kw >> 32))};
    const f32x4 vv = (f32x4){bflo((unsigned)vw), bfhi((unsigned)vw), bflo((unsigned)(vw >> 32)), bfhi((unsigned)(vw >> 32))};
    const f32x4 gg = (f32x4){bflo((unsigned)gw), bfhi((unsigned)gw), bflo((unsigned)(gw >> 32)), bfhi((unsigned)(gw >> 32))};
    const float qk = wave_sum((q4[0] * k4[0] + q4[1] * k4[1]) + (q4[2] * k4[2] + q4[3] * k4[3]));
    const float gam = gamma_h(h);
    const f32x4* S0 = (const f32x4*)(p.in[I_SRET] + (size_t)su * 65536) + lane; f32x4* Sn = (f32x4*)(p.out + O_RETS + (size_t)su * 65536) + lane;
    f32x4 acc = (f32x4){0.f, 0.f, 0.f, 0.f};
#pragma unroll 1
    for (int l0 = 0; l0 < 64; l0 += 8) {
        f32x4 s4[32];
#pragma unroll
        for (int e = 0; e < 32; ++e) s4[e] = S0[(size_t)(l0 * 4 + e) * 64];
        __builtin_amdgcn_sched_barrier(0);
#pragma unroll
        for (int e = 0; e < 32; ++e) {
            const int l = l0 + (e >> 2), j = e & 3;
            const float qd = __builtin_bit_cast(float, __builtin_amdgcn_readlane(__builtin_bit_cast(int, q4[j]), l));
            const float kd = __builtin_bit_cast(float, __builtin_amdgcn_readlane(__builtin_bit_cast(int, k4[j]), l));
            acc += s4[e] * qd;
            Sn[(size_t)(l0 * 4 + e) * 64] = s4[e] * gam + vv * kd;
        }
        __builtin_amdgcn_sched_barrier(0);
    }
    const f32x4 o = vv * qk + acc * gam;
    const float mean = wave_sum((o.x + o.y) + (o.z + o.w)) * (1.f / 256.f);
    const f32x4 oc = o - mean;
    const float var = wave_sum((oc.x * oc.x + oc.y * oc.y) + (oc.z * oc.z + oc.w * oc.w)) * (1.f / 256.f);
    const float rstd = 1.f / sqrtf(var + 1e-5f);
    const f32x4 g4 = ((const f32x4*)(p.in[I_GBG] + h * 256))[lane], b4 = ((const f32x4*)(p.in[I_GBB] + h * 256))[lane];
    const f32x4 yn = oc * rstd * g4 + b4;
    *(unsigned long long*)((bf16*)(p.ws + WS_MIX) + (size_t)row * DM + DA + h * 256 + lane * 4) =
        (unsigned long long)pk2(yn.x * siluf_(gg.x), yn.y * siluf_(gg.y)) | ((unsigned long long)pk2(yn.z * siluf_(gg.z), yn.w * siluf_(gg.w)) << 32);
}
__device__ __forceinline__ void ret_sample_unit(const Params& p, int su, LAS unsigned char* lds, const int tid_) {
    const int tid = tid_, wave = tid >> 6, lane = tid & 63;
    const int s = su >> 2, h = su & 3, row = MP + s;
    const bf16* zr = (const bf16*)(p.ws + WS_ZB) + (size_t)row * ZBW;
    LAS float* qs = (LAS float*)lds; LAS float* ks = qs + 256; LAS float* red = ks + 256;
    LAS float* st = red + 2048;
    if (tid < 256) { qs[tid] = bf2f(zr[ZB_Q + h * 256 + tid]); ks[tid] = bf2f(zr[ZB_K + h * 256 + tid]); }
    __syncthreads();
    float qk = 0.f;
#pragma unroll
    for (int j = 0; j < 4; ++j) qk += qs[lane * 4 + j] * ks[lane * 4 + j];
    qk = wave_sum(qk);
    const float gam = gamma_h(h);
    const int vq = lane, dp = wave;
    f32x4 vv; { const bf16* vp = zr + ZB_V + h * 256 + vq * 4; vv = (f32x4){bf2f(vp[0]), bf2f(vp[1]), bf2f(vp[2]), bf2f(vp[3])}; }
    const float* S0 = p.in[I_SRET] + (size_t)su * 65536; float* Sn = p.out + O_RETS + (size_t)su * 65536;
    f32x4 acc = (f32x4){0.f, 0.f, 0.f, 0.f};
#pragma unroll 8
    for (int i = 0; i < 32; ++i) {
        const int d = dp * 32 + i;
        const f32x4 s4 = ((const f32x4*)(S0 + (size_t)d * 256))[vq];
        acc += s4 * qs[d];
        ((f32x4*)(Sn + (size_t)d * 256))[vq] = s4 * gam + vv * ks[d];
    }
    *(LAS f32x4*)(red + dp * 256 + vq * 4) = acc;
    __syncthreads();
    float o = 0.f;
    if (tid < 256) {
        float sm = 0.f;
#pragma unroll
        for (int j = 0; j < 8; ++j) sm += red[j * 256 + tid];
        o = qk * bf2f(zr[ZB_V + h * 256 + tid]) + gam * sm;
        const float s1 = wave_sum(o), s2 = wave_sum(o * o);
        if (lane == 0) { st[wave * 2] = s1; st[wave * 2 + 1] = s2; }
    }
    __syncthreads();
    if (tid < 256) {
        const float s1 = st[0] + st[2] + st[4] + st[6], s2 = st[1] + st[3] + st[5] + st[7];
        const float mean = s1 * (1.f / 256.f), var = fmaxf(s2 * (1.f / 256.f) - mean * mean, 0.f);
        const float yn = (o - mean) / sqrtf(var + 1e-5f) * p.in[I_GBG][h * 256 + tid] + p.in[I_GBB][h * 256 + tid];
        const float g = bf2f(zr[ZB_G + h * 256 + tid]);
        ((bf16*)(p.ws + WS_MIX))[(size_t)row * DM + DA + h * 256 + tid] = (bf16)f2bf(yn * siluf_(g));
    }
    __syncthreads();
}

__device__ __forceinline__ void phase3(const Params& p, LAS unsigned char* lds, const int tid_) {
    const int wave = __builtin_amdgcn_readfirstlane(tid_ >> 6), lane = tid_ & 63;
    const int blk = blockIdx.x;
    __syncthreads();
    if (tid_ < 32) ((LAS unsigned*)(lds + CR_FULL))[tid_] = 0u;
    __syncthreads();
    if (blk < 64) {
        if (wave < 4) chunk_scan(p, blk, wave, lane, lds);
        else chunk_loader(p.ws + WS_CH + (size_t)blk * 128 * CH_BYTES, lds, wave - 4, lane);
        return;
    }
    const int nb = (int)gridDim.x - 64, sw = (blk - 64) + nb * wave, NSW = nb * 8;
    if (nb == 192) {
        const int bq = blk - 64;
        if (wave < 2 || (wave == 2 && bq < 128)) { ret_sample_task(p, wave * 192 + bq, lane); return; }
        const int xcd = blk & 7, li = wave >= 3 ? (wave - 3) * 24 + (bq >> 3) : 120 + ((bq - 128) >> 3);
        const int oi = xcd * 128 + li;
        stepA_task(p, (xcd * 2 + (li >> 6)) * 64 + (li & 63), lane);
        wkv_sample_unit(p, oi, lane); wkv_sample_unit(p, oi + 1024, lane);
        return;
    }
    for (int u = sw; u < MS * 4; u += NSW) ret_sample_task(p, u, lane);
    for (int u = sw; u < MS * 16; u += NSW) wkv_sample_unit(p, u, lane);
    for (int u = sw; u < 1024; u += NSW) stepA_task(p, u, lane);
}

__device__ __forceinline__ void phase4(const Params& p, const int tid_) {
    const int gw = blockIdx.x * 8 + (tid_ >> 6), NGW = gridDim.x * 8, lane = tid_ & 63, hq = lane >> 4, c4 = (lane & 15) * 4;
    const float* YA = (const float*)(p.ws + WS_YA); const bf16* ZB = (const bf16*)(p.ws + WS_ZB); bf16* MIX = (bf16*)(p.ws + WS_MIX);
    const f32x4 rkA[4] = {*(const f32x4*)(p.in[I_RK] + 0 * 256 + lane * 4), *(const f32x4*)(p.in[I_RK] + 1 * 256 + lane * 4), *(const f32x4*)(p.in[I_RK] + 2 * 256 + lane * 4), *(const f32x4*)(p.in[I_RK] + 3 * 256 + lane * 4)};
    constexpr int NU = 4;
    for (int u0 = gw * NU; u0 < MT * 4; u0 += NGW * NU) {
        f32x4 y[NU], r[NU], k2[NU], v[NU]; unsigned long long gwd[NU], vbw[NU];
#pragma unroll
        for (int i = 0; i < NU; ++i) {
            const int u = u0 + i, row = u >> 2, h = (u & 3) * 4 + hq, ch = h * 64 + c4;
            y[i] = *(const f32x4*)(YA + (size_t)row * DA + ch);
            gwd[i] = *(const unsigned long long*)(ZB + (size_t)row * ZBW + ZB_GA + ch);
            if (row < MP) { vbw[i] = *(const unsigned long long*)((const bf16*)(p.ws + WS_OPSA) + (size_t)row * DA + ch); r[i] = k2[i] = v[i] = (f32x4){0.f, 0.f, 0.f, 0.f}; }
            else { const float* base = (const float*)(p.ws + WS_OPSS) + ((size_t)(row - MP) * 16 + h) * 384;
                   r[i] = *(const f32x4*)(base + 256 + c4); k2[i] = *(const f32x4*)(base + 192 + c4); v[i] = *(const f32x4*)(base + 320 + c4); vbw[i] = 0ull; }
        }
        __builtin_amdgcn_sched_barrier(0);
#pragma unroll
        for (int i = 0; i < NU; ++i) {
            const int u = u0 + i, row = u >> 2, h = (u & 3) * 4 + hq, ch = h * 64 + c4;
            const f32x4 rk = rkA[i], gg = *(const f32x4*)(p.in[I_GAG] + ch), gb = *(const f32x4*)(p.in[I_GAB] + ch);
            const float mean = row16_sum((y[i].x + y[i].y) + (y[i].z + y[i].w)) * (1.f / 64.f);
            const f32x4 yc = y[i] - mean;
            const float var = row16_sum((yc.x * yc.x + yc.y * yc.y) + (yc.z * yc.z + yc.w * yc.w)) * (1.f / 64.f);
            const float bsum = row16_sum((r[i].x * k2[i].x * rk.x + r[i].y * k2[i].y * rk.y) + (r[i].z * k2[i].z * rk.z + r[i].w * k2[i].w * rk.w));
            const float rstd = 1.f / sqrtf(var + 64e-5f);
            const f32x4 bon = row < MP ? (f32x4){bflo((unsigned)vbw[i]), bfhi((unsigned)vbw[i]), bflo((unsigned)(vbw[i] >> 32)), bfhi((unsigned)(vbw[i] >> 32))} : v[i] * bsum;
            const f32x4 yn = yc * rstd * gg + gb + bon;
            const f32x4 gt4 = (f32x4){bflo((unsigned)gwd[i]), bfhi((unsigned)gwd[i]), bflo((unsigned)(gwd[i] >> 32)), bfhi((unsigned)(gwd[i] >> 32))};
            *(unsigned long long*)(MIX + (size_t)row * DM + ch) =
                (unsigned long long)pk2(yn.x * siluf_(gt4.x), yn.y * siluf_(gt4.y)) | ((unsigned long long)pk2(yn.z * siluf_(gt4.z), yn.w * siluf_(gt4.w)) << 32);
        }
    }
}

__device__ __forceinline__ void stepC_unit(const Params& p, int unit, LAS unsigned char* lds, const int tid_) {
    const int tid = tid_, wave = tid >> 6, lane = tid & 63, fr = lane & 15, fq = lane >> 4;
    const int bh = unit >> 4, c = unit & 15, b = bh >> 2, h = bh & 3, wr = wave >> 1, wc = wave & 1;
    const int rowb = b * 2048 + c * 128;
    const bf16* ZB = (const bf16*)(p.ws + WS_ZB);
    const bf16* Q = ZB + (size_t)rowb * ZBW + ZB_Q + h * 256;
    const bf16* Kp = ZB + (size_t)rowb * ZBW + ZB_K + h * 256;
    const bf16* VT = (const bf16*)(p.ws + WS_VT) + (size_t)bh * 256 * 2048 + c * 128;
    const bf16* ST = (const bf16*)(p.ws + WS_ST) + ((size_t)(bh * 16 + c) << 16);
    LAS bf16* Pl = (LAS bf16*)lds;
    LAS bf16* Qs = Pl + 128 * 136;
    LAS float* red = (LAS float*)(lds + 110592);
    const float lg = logf(gamma_h(h));
    for (int e = tid; e < 4096; e += 512) {
        const int i = e >> 5, dc = e & 31;
        const u32x4 w = *(const u32x4*)(Q + (size_t)i * ZBW + dc * 8);
        const float sc = expf((float)(i + 1) * lg);
        u32x4 o; o.x = pk2(bflo(w.x) * sc, bfhi(w.x) * sc); o.y = pk2(bflo(w.y) * sc, bfhi(w.y) * sc); o.z = pk2(bflo(w.z) * sc, bfhi(w.z) * sc); o.w = pk2(bflo(w.w) * sc, bfhi(w.w) * sc);
        *(LAS u32x4*)(Qs + i * 264 + dc * 8) = o;
    }
    {
        f32x4 sa[2][4];
#pragma unroll
        for (int m = 0; m < 2; ++m)
#pragma unroll
            for (int n = 0; n < 4; ++n) sa[m][n] = (f32x4){0.f, 0.f, 0.f, 0.f};
#pragma unroll 1
        for (int ks = 0; ks < 8; ++ks) {
            bf16x8 A[2];
            const bf16* qa = Q + (size_t)(wr * 32 + fr) * ZBW + ks * 32 + fq * 8; const bf16* kb = Kp + (size_t)(wc * 64 + fr) * ZBW + ks * 32 + fq * 8;
            asm volatile("" : "+v"(qa), "+v"(kb));
#pragma unroll
            for (int m = 0; m < 2; ++m) A[m] = *(const bf16x8*)(qa + (size_t)(m * 16) * ZBW);
            bf16x8 B[4];
#pragma unroll
            for (int n = 0; n < 4; ++n) B[n] = *(const bf16x8*)(kb + (size_t)(n * 16) * ZBW);
            __builtin_amdgcn_sched_barrier(0);
#pragma unroll
            for (int n = 0; n < 4; ++n)
#pragma unroll
                for (int m = 0; m < 2; ++m) sa[m][n] = __builtin_amdgcn_mfma_f32_16x16x32_bf16(B[n], A[m], sa[m][n], 0, 0, 0);
        }
#pragma unroll
        for (int m = 0; m < 2; ++m)
#pragma unroll
            for (int n = 0; n < 4; ++n)
            {
                const int i = wr * 32 + m * 16 + fr, j0 = wc * 64 + n * 16 + fq * 4;
                float pv[4];
#pragma unroll
                for (int r = 0; r < 4; ++r) pv[r] = i >= j0 + r ? sa[m][n][r] * __expf((float)(i - j0 - r) * lg) : 0.f;
                *(LAS unsigned long long*)(Pl + i * 136 + j0) = (unsigned long long)pk2(pv[0], pv[1]) | ((unsigned long long)pk2(pv[2], pv[3]) << 32);
            }
    }
    __syncthreads();
    f32x4 oa[2][8];
#pragma unroll
    for (int m = 0; m < 2; ++m)
#pragma unroll
        for (int n = 0; n < 8; ++n) oa[m][n] = (f32x4){0.f, 0.f, 0.f, 0.f};
#pragma unroll 1
    for (int ks = 0; ks < 4; ++ks) {
        bf16x8 A[2];
        const bf16* vb = VT + (size_t)(wc * 128 + fr) * 2048 + ks * 32 + fq * 8;
        asm volatile("" : "+v"(vb));
#pragma unroll
        for (int m = 0; m < 2; ++m) A[m] = *(LAS const bf16x8*)(Pl + (wr * 32 + m * 16 + fr) * 136 + ks * 32 + fq * 8);
        bf16x8 B[8];
#pragma unroll
        for (int n = 0; n < 8; ++n) B[n] = *(const bf16x8*)(vb + (size_t)(n * 16) * 2048);
        __builtin_amdgcn_sched_barrier(0);
#pragma unroll
        for (int n = 0; n < 8; ++n)
#pragma unroll
            for (int m = 0; m < 2; ++m) oa[m][n] = __builtin_amdgcn_mfma_f32_16x16x32_bf16(B[n], A[m], oa[m][n], 0, 0, 0);
    }
    if (c > 0) {
#pragma unroll 1
        for (int ks = 0; ks < 8; ++ks) {
            bf16x8 A[2];
            const bf16* sb = ST + (size_t)(wc * 128 + fr) * 256 + ks * 32 + fq * 8;
            asm volatile("" : "+v"(sb));
#pragma unroll
            for (int m = 0; m < 2; ++m) A[m] = *(LAS const bf16x8*)(Qs + (wr * 32 + m * 16 + fr) * 264 + ks * 32 + fq * 8);
            bf16x8 B[8];
#pragma unroll
            for (int n = 0; n < 8; ++n) B[n] = *(const bf16x8*)(sb + (size_t)(n * 16) * 256);
            __builtin_amdgcn_sched_barrier(0);
#pragma unroll
            for (int n = 0; n < 8; ++n)
#pragma unroll
                for (int m = 0; m < 2; ++m) oa[m][n] = __builtin_amdgcn_mfma_f32_16x16x32_bf16(B[n], A[m], oa[m][n], 0, 0, 0);
        }
    }
#pragma unroll
    for (int m = 0; m < 2; ++m) {
        float s1 = 0.f, s2 = 0.f;
#pragma unroll
        for (int n = 0; n < 8; ++n) { const f32x4 v = oa[m][n]; s1 += (v.x + v.y) + (v.z + v.w); s2 += (v.x * v.x + v.y * v.y) + (v.z * v.z + v.w * v.w); }
        s1 += __shfl_xor(s1, 16); s1 += __shfl_xor(s1, 32); s2 += __shfl_xor(s2, 16); s2 += __shfl_xor(s2, 32);
        if (fq == 0) { const int i = wr * 32 + m * 16 + fr; red[(i * 2 + wc) * 2] = s1; red[(i * 2 + wc) * 2 + 1] = s2; }
    }
    __syncthreads();
    bf16* MIX = (bf16*)(p.ws + WS_MIX);
#pragma unroll
    for (int m = 0; m < 2; ++m) {
        const int i = wr * 32 + m * 16 + fr;
        const float s1 = red[i * 4] + red[i * 4 + 2], s2 = red[i * 4 + 1] + red[i * 4 + 3];
        const float mean = s1 * (1.f / 256.f), var = fmaxf(s2 * (1.f / 256.f) - mean * mean, 0.f), rstd = 1.f / sqrtf(var + 1e-5f);
#pragma unroll
        for (int n = 0; n < 8; ++n) {
            const int v0 = wc * 128 + n * 16 + 4 * fq;
            const f32x4 gg = *(const f32x4*)(p.in[I_GBG] + h * 256 + v0), gb = *(const f32x4*)(p.in[I_GBB] + h * 256 + v0);
            const unsigned long long gw = *(const unsigned long long*)(ZB + (size_t)(rowb + i) * ZBW + ZB_G + h * 256 + v0);
            const f32x4 g4 = (f32x4){bflo((unsigned)gw), bfhi((unsigned)gw), bflo((unsigned)(gw >> 32)), bfhi((unsigned)(gw >> 32))};
            const f32x4 yn = (oa[m][n] - mean) * rstd * gg + gb;
            *(unsigned long long*)(MIX + (size_t)(rowb + i) * DM + DA + h * 256 + v0) =
                (unsigned long long)pk2(yn.x * siluf_(g4.x), yn.y * siluf_(g4.y)) | ((unsigned long long)pk2(yn.z * siluf_(g4.z), yn.w * siluf_(g4.w)) << 32);
        }
    }
    __syncthreads();
}

__device__ __forceinline__ void phase8(const Params& p, const int tid_) {
    const int gw = blockIdx.x * 8 + (tid_ >> 6), NGW = gridDim.x * 8, lane = tid_ & 63;
    const float* rss = (const float*)(p.ws + WS_RSS); const float* g = p.in[I_GFIN];
    for (int row = gw; row < MT; row += NGW) {
        const float rstd = 1.f / sqrtf(rss[row] * (1.f / DM) + 1e-6f);
        f32x4* o = (f32x4*)(p.out + (size_t)row * DM); const bf16* h3 = (const bf16*)(p.ws + WS_H2) + (size_t)row * DM;
#pragma unroll
        for (int j = 0; j < 8; ++j) { const f32x4 gg = ((const f32x4*)g)[lane + 64 * j]; o[lane + 64 * j] = ldz4(h3 + (lane + 64 * j) * 4) * rstd * gg; }
    }
}

__device__ __forceinline__ void skinny_block(const bf16* A, const bf16* Bt, int r0, int c0, LAS unsigned char* lds, const int tid_, float (&res)[2]) {
    const int wave = tid_ >> 6, lane = tid_ & 63, fr = lane & 15, fq = lane >> 4;
    const bf16* a = A + (size_t)(r0 + fr) * DM + wave * 256 + fq * 8; const bf16* bp = Bt + (size_t)(c0 + fr) * DM + wave * 256 + fq * 8;
    bf16x8 bv[8], av[4][8];
#pragma unroll
    for (int ks = 0; ks < 8; ++ks) bv[ks] = *(const bf16x8*)(bp + ks * 32);
#pragma unroll
    for (int m = 0; m < 4; ++m)
#pragma unroll
        for (int ks = 0; ks < 8; ++ks) av[m][ks] = *(const bf16x8*)(a + (size_t)(m * 16) * DM + ks * 32);
    __builtin_amdgcn_sched_barrier(0);
    LAS float* red = (LAS float*)lds;
#pragma unroll
    for (int m = 0; m < 4; ++m) {
        f32x4 acc = (f32x4){0.f, 0.f, 0.f, 0.f};
#pragma unroll
        for (int ks = 0; ks < 8; ++ks) acc = __builtin_amdgcn_mfma_f32_16x16x32_bf16(av[m][ks], bv[ks], acc, 0, 0, 0);
#pragma unroll
        for (int r = 0; r < 4; ++r) red[((wave * 4 + m) * 16 + 4 * fq + r) * 16 + fr] = acc[r];
    }
    __syncthreads();
#pragma unroll
    for (int j = 0; j < 2; ++j) {
        const int o = tid_ + j * 512;
        float s = 0.f;
#pragma unroll
        for (int w = 0; w < 8; ++w) s += red[w * 1024 + o];
        res[j] = s;
    }
    __syncthreads();
}
__device__ __forceinline__ void skinny_gemm2(const Params& p, LAS unsigned char* lds, const int tid_) {
    const int r0 = MP + (blockIdx.x & 1) * 64, c0 = (blockIdx.x >> 1) * 16;
    if (blockIdx.x >= 256) return;
    float res[2];
    skinny_block((const bf16*)(p.ws + WS_MIX), (const bf16*)(p.ws + WS_WOUTT), r0, c0, lds, tid_, res);
#pragma unroll
    for (int j = 0; j < 2; ++j) {
        const int o = tid_ + j * 512, row = r0 + (o >> 4), col = c0 + (o & 15);
        const float v = res[j] + p.in[I_XS][(size_t)(row - MP) * DM + col];
        ((bf16*)(p.ws + WS_H2B))[(size_t)row * DM + col] = (bf16)f2bf(v);
    }
}
__device__ __forceinline__ void skinny_gemm3(const Params& p, LAS unsigned char* lds, const int tid_) {
    const int r0 = MP + (blockIdx.x & 1) * 64, c0 = (blockIdx.x >> 1) * 16;
    if (blockIdx.x >= 256) return;
    float res[2];
    skinny_block((const bf16*)(p.ws + WS_H2B), (const bf16*)(p.ws + WS_WGT), r0, c0, lds, tid_, res);
#pragma unroll
    for (int j = 0; j < 2; ++j) {
        const int o = tid_ + j * 512, row = r0 + (o >> 4), col = c0 + (o & 15);
        const float h2 = bf2f(((const bf16*)(p.ws + WS_H2B))[(size_t)row * DM + col]), pl = bf2f(((const bf16*)(p.ws + WS_PLE))[(size_t)row * DM + col]);
        const float ov = h2 + sigmoidf_(res[j]) * pl;
        ((bf16*)(p.ws + WS_H2))[(size_t)row * DM + col] = (bf16)f2bf(ov);
        const float ss = row16_sum(ov * ov);
        if ((tid_ & 15) == 0) atomicAdd((float*)(p.ws + WS_RSS) + row, ss);
    }
}
#ifndef REP1
#define REP1 1
#endif
#ifndef REP5
#define REP5 1
#endif
#ifndef REP6
#define REP6 1
#endif
#ifndef REP0
#define REP0 1
#endif
#ifndef REP2
#define REP2 1
#endif
#ifndef REP3
#define REP3 1
#endif
#ifndef REP4
#define REP4 1
#endif
#define XB_TMO      128
#define XB_XCNT(j)  (256  + 64 * (j))
#define XB_XSUB(j)  (1280 + 64 * (j))
#define XB_XGEN(j)  (2304 + 64 * (j))
#define XB_TOP      3328
#define XB_TOPGEN   3392
#define XCD_BAR_WORDS 3456
#define XB_SPIN_CAP (1u << 18)

__device__ __forceinline__ unsigned xb_ld(unsigned* p)              { return __hip_atomic_load(p, __ATOMIC_RELAXED, __HIP_MEMORY_SCOPE_AGENT); }
__device__ __forceinline__ unsigned xb_add(unsigned* p, unsigned v) { return __hip_atomic_fetch_add(p, v, __ATOMIC_RELAXED, __HIP_MEMORY_SCOPE_AGENT); }
__device__ __forceinline__ unsigned xb_xcc_id() { return (unsigned)__builtin_amdgcn_s_getreg((3 << 11) | 20) & 0xFu; }
#define XB_SPIN(cond, bar) do { unsigned _sp = 0; while (cond) { __builtin_amdgcn_s_sleep(1); \
    if ((++_sp & 255u) == 0u) { if (xb_ld(&(bar)[XB_TMO])) break; if (_sp > XB_SPIN_CAP) { atomicAdd(&(bar)[XB_TMO], 1u); break; } } } } while (0)

struct XcdBarrier {
    unsigned* bar; unsigned x;
    volatile LAS unsigned* st;
};

__device__ __forceinline__ XcdBarrier xcd_barrier_post(unsigned* bar, volatile LAS unsigned* st, const int tid_) {
    XcdBarrier b; b.bar = bar; b.x = xb_xcc_id(); b.st = st;
    if (tid_ == 0) (void)xb_add(&bar[XB_XCNT(b.x)], 1u);
    return b;
}
__device__ __forceinline__ void xcd_barrier_complete(unsigned* bar, unsigned x, unsigned& nloc, unsigned& nx) {
    const unsigned G = gridDim.x * gridDim.y * gridDim.z;
    unsigned sum, cnt, mine, sp = 0u;
    for (;;) {
        sum = 0u; cnt = 0u; mine = 0u;
#pragma unroll
        for (unsigned j = 0; j < 16; ++j) { const unsigned c = xb_ld(&bar[XB_XCNT(j)]); sum += c; cnt += (c > 0u) ? 1u : 0u; mine = (j == x) ? c : mine; }
        if (sum == G) break;
        __builtin_amdgcn_s_sleep(1);
        if ((++sp & 255u) == 0u) { if (xb_ld(&bar[XB_TMO])) break; if (sp > XB_SPIN_CAP) { atomicAdd(&bar[XB_TMO], 1u); break; } }
    }
    nloc = mine > 0u ? mine : 1u; nx = cnt > 0u ? cnt : 1u;
}

__device__ __forceinline__ void xcd_barrier(const XcdBarrier& b, const int tid_) {
    asm volatile("s_waitcnt vmcnt(0)" ::: "memory");
    __syncthreads();
    if (tid_ == 0) {
        unsigned* bar = b.bar;
        __builtin_amdgcn_s_waitcnt(0);
        unsigned nloc = b.st[0], nx = b.st[1];
        if (nloc == 0u) { xcd_barrier_complete(bar, b.x, nloc, nx); b.st[0] = nloc; b.st[1] = nx; }
        const unsigned old = xb_add(&bar[XB_XSUB(b.x)], 1u);
        const unsigned gen = old / nloc;
        if (old + 1u == (gen + 1u) * nloc) {
            __builtin_amdgcn_fence(__ATOMIC_RELEASE, "agent");
            asm volatile("s_waitcnt vmcnt(0)" ::: "memory");
            const unsigned og = xb_add(&bar[XB_TOP], 1u);
            const unsigned tg = og / nx;
            if (og + 1u == (tg + 1u) * nx) xb_add(&bar[XB_TOPGEN], 1u);
            else XB_SPIN(xb_ld(&bar[XB_TOPGEN]) == tg, bar);
            __builtin_amdgcn_fence(__ATOMIC_ACQUIRE, "agent");
            xb_add(&bar[XB_XGEN(b.x)], 1u);
            asm volatile("s_waitcnt vmcnt(0)" ::: "memory");
        } else {
            XB_SPIN(xb_ld(&bar[XB_XGEN(b.x)]) == gen, bar);
            __builtin_amdgcn_fence(__ATOMIC_ACQUIRE, "agent");
            asm volatile("s_waitcnt vmcnt(0)" ::: "memory");
        }
    }
    __syncthreads();
}

__global__ void __launch_bounds__(512, 2) mega(Params p_) {
    extern __shared__ __attribute__((aligned(16))) unsigned char lds_raw[];
    LAS unsigned char* lds = (LAS unsigned char*)lds_raw;
    const int lo = p_.ph_lo, hi = p_.ph_hi;
#ifdef ONLY_PHASE
#define IN(k) ((k) == ONLY_PHASE && lo <= (k) && (k) < hi)
#else
#define IN(k) (lo <= (k) && (k) < hi)
#endif
#define SEAM(k) do { if (IN(k) && IN((k) + 1)) { const int tid_ = my_tid(wv); XcdBarrier bb; bb.bar = (unsigned*)(kparams().ws + WS_CTL); bb.x = xb_xcc_id(); bb.st = (volatile LAS unsigned*)(lds + 133120); xcd_barrier(bb, tid_); } } while (0)
    volatile LAS unsigned* bst = (volatile LAS unsigned*)(lds + 133120);
    const int tid0 = threadIdx.x; const int wv = __builtin_amdgcn_readfirstlane(tid0 >> 6);
    if (tid0 < 16) bst[tid0] = 0u;
    __syncthreads();
    if (hi - lo > 1) (void)xcd_barrier_post((unsigned*)(kparams().ws + WS_CTL), bst, tid0);
    if (hi == 12345) cg::this_grid().sync();
    if (IN(0)) { const Params& p = kparams(); unsigned char* ws = p.ws; (void)ws; const int tid_ = my_tid(wv); for (int rep = 0; rep < REP0; ++rep) phase0(p, lds, tid_); } SEAM(0);
    if (IN(1)) { const Params& p = kparams(); unsigned char* ws = p.ws; (void)ws; const int tid_ = my_tid(wv);
        pg8::Gemm g{(const bf16*)(ws + WS_XN), (const bf16*)(ws + WS_WINT), MPAD, NCPAD, DM}; pg8::StaticOrder S; S.init(MPAD, NCPAD, gridDim.x, blockIdx.x);
        Epi1 E{(bf16*)(ws + WS_ZA), (bf16*)(ws + WS_ZB), (const float2*)(ws + WS_ROT)};
        for (int rep = 0; rep < REP1; ++rep) pg8::gemm_phase<Epi1, pg8::StaticOrder, true, true>(lds, g, S, E, tid_);
    } SEAM(1);
    if (IN(2)) { const Params& p = kparams(); unsigned char* ws = p.ws; (void)ws; const int tid_ = my_tid(wv); for (int rep = 0; rep < REP2; ++rep) phase2(p, lds, tid_); } SEAM(2);
    if (IN(3)) { const Params& p = kparams(); unsigned char* ws = p.ws; (void)ws; const int tid_ = my_tid(wv); for (int rep = 0; rep < REP3; ++rep) phase3(p, lds, tid_); } SEAM(3);
    if (IN(4)) { const Params& p = kparams(); unsigned char* ws = p.ws; (void)ws; const int tid_ = my_tid(wv); for (int rep = 0; rep < REP4; ++rep) phase4(p, tid_); }
    if (IN(5)) { const Params& p = kparams(); unsigned char* ws = p.ws; (void)ws; const int tid_ = my_tid(wv);
#ifndef SKC
        for (int rep = 0; rep < REP5; ++rep) for (int u = blockIdx.x; u < 256; u += gridDim.x) stepC_unit(p, u, lds, tid_);
#endif
        { pg8::Gemm g{(const bf16*)(ws + WS_PB), (const bf16*)(ws + WS_WPLET), MPAD, DM, 256}; pg8::StaticOrder S; S.init(MPAD, DM, gridDim.x, blockIdx.x);
          EpiPle E{(bf16*)(ws + WS_PLE)};
#ifndef SKPLE
          pg8::gemm_phase<EpiPle, pg8::StaticOrder, true, true>(lds, g, S, E, tid_);
#endif
        }
    } SEAM(5);
    if (IN(6)) { const Params& p = kparams(); unsigned char* ws = p.ws; (void)ws; const int tid_ = my_tid(wv);
        skinny_gemm2(p, lds, tid_);
        { pg8::Gemm g{(const bf16*)(ws + WS_MIX), (const bf16*)(ws + WS_WOUTT), MP, DM, DM}; pg8::StaticOrder S; S.init(MP, DM, gridDim.x, blockIdx.x);
          Epi2 E{p.in[I_XP], p.in[I_XS], (float*)(ws + WS_H2), (bf16*)(ws + WS_H2B)};
          for (int rep = 0; rep < REP6; ++rep) pg8::gemm_phase<Epi2, pg8::StaticOrder, true, true>(lds, g, S, E, tid_); }
    } SEAM(6);
    if (IN(7)) { const Params& p = kparams(); unsigned char* ws = p.ws; (void)ws; const int tid_ = my_tid(wv);
        skinny_gemm3(p, lds, tid_);
        pg8::Gemm g{(const bf16*)(ws + WS_H2B), (const bf16*)(ws + WS_WGT), MP, DM, DM}; pg8::StaticOrder S; S.init(MP, DM, gridDim.x, blockIdx.x);
        Epi3 E{(const bf16*)(ws + WS_H2B), (const bf16*)(ws + WS_PLE), (bf16*)(ws + WS_H2), (float*)(ws + WS_RSS)};
        pg8::gemm_phase<Epi3, pg8::StaticOrder, true, true>(lds, g, S, E, tid_);
    } SEAM(7);
    if (IN(8)) { const Params& p = kparams(); unsigned char* ws = p.ws; (void)ws; const int tid_ = my_tid(wv); phase8(p, tid_); }
#undef IN
#undef SEAM
}

#ifndef N_LAUNCH_PER_PHASE
#define N_LAUNCH_PER_PHASE 0
#endif
extern "C" void kernel_launch(void* const* d_in, const int* in_sizes, int n_in, void* d_out, int out_size, void* d_ws, size_t ws_size, hipStream_t stream) {
    static int grid = 0;
    if (grid == 0) {
        if (n_in != 25 || ws_size < WS_END) { fprintf(stderr, "kernel_launch: unexpected inputs (n_in %d, ws %zu < %zu)\n", n_in, ws_size, (size_t)WS_END); grid = -1; return; }
        int dev = 0, cus = 0, per_cu = 0;
        hipGetDevice(&dev); hipDeviceGetAttribute(&cus, hipDeviceAttributeMultiprocessorCount, dev);
        if (hipFuncSetAttribute((const void*)mega, hipFuncAttributeMaxDynamicSharedMemorySize, LDS_BYTES) != hipSuccess) { fprintf(stderr, "hipFuncSetAttribute failed\n"); grid = -1; return; }
        hipOccupancyMaxActiveBlocksPerMultiprocessor(&per_cu, (const void*)mega, 512, LDS_BYTES);
        if (per_cu < 1) per_cu = 1;
        grid = cus * per_cu;
        (void)hipGetLastError();
    }
    if (grid < 0) return;
    Params p{};
    for (int i = 0; i < 25; ++i) p.in[i] = (const float*)d_in[i];
    p.out = (float*)d_out; p.ws = (unsigned char*)d_ws;
#if N_LAUNCH_PER_PHASE
    for (int ph = 0; ph < 9; ++ph) { p.ph_lo = ph; p.ph_hi = ph + 1; hipLaunchKernelGGL(mega, dim3(grid), dim3(512), LDS_BYTES, stream, p); }
#else
    p.ph_lo = 0; p.ph_hi = 9;
    (void)hipMemsetAsync(d_ws, 0, 16384, stream);
    void* args[] = {&p};
    hipError_t e = hipLaunchCooperativeKernel((const void*)mega, dim3(grid), dim3(512), args, LDS_BYTES, stream);
    if (e != hipSuccess) fprintf(stderr, "cooperative launch failed: %s (grid %d)\n", hipGetErrorString(e), grid);
#endif
}
```
